# Optimizing an MI355X kernel written in HIP

```python
import jax, jax.numpy as jnp
from jax import lax
import numpy as np

D_MODEL = 1024
BATCH = 2
SEQ = 8192
DEPTH = 2

CHUNK = 64
CONV_W = 4
BR_W = 512
N_BRANCH = 3
DN_HEADS = 4
DN_DK = 128
DN_DV = 128
LRU_W = BR_W
LRU_BLOCKS = 8
LRU_BLK = LRU_W // LRU_BLOCKS
LRU_C = 8.0
LA_HEADS = 8
LA_HD = 64
LA_PAST = 8
LA_BAND = (LA_PAST + 1) * CHUNK
REL_CLIP = 128
MEM_LEN = 256
XA_HEADS = 4
XA_HD = D_MODEL // XA_HEADS
D_FF = 2816
ALPHA = (2 * DEPTH) ** 0.25
BETA = (8 * DEPTH) ** -0.25
LN_EPS = 1e-5
NORM_EPS = 1e-6
NEG_INF = -1e30

SPLITS = (DN_HEADS * DN_DK, DN_HEADS * DN_DK, DN_HEADS * DN_DV, DN_HEADS * DN_DV,
          DN_HEADS, DN_HEADS, LRU_W, LRU_W, LA_HEADS * LA_HD, LA_HEADS * LA_HD,
          LA_HEADS * LA_HD, N_BRANCH * D_MODEL)
N_IN = sum(SPLITS)

kernel_name = "hybrid_deltanet_rglru_chunkattn_deepnorm"


def layer_norm(x, g, b):
    xf = x.astype(jnp.float32)
    mu = xf.mean(-1, keepdims=True)
    var = jnp.square(xf - mu).mean(-1, keepdims=True)
    return ((xf - mu) * lax.rsqrt(var + LN_EPS) * g.astype(jnp.float32)
            + b.astype(jnp.float32)).astype(x.dtype)


def swiglu(x, w12, w3):
    g, u = jnp.split(x @ w12, 2, axis=-1)
    return (jax.nn.silu(g) * u) @ w3


def causal_dwconv(x, w):
    c = x.shape[-1]
    return lax.conv_general_dilated(
        x, w[:, None, :].astype(x.dtype), window_strides=(1,),
        padding=[(CONV_W - 1, 0)], dimension_numbers=('NWC', 'WIO', 'NWC'),
        feature_group_count=c)


def l2norm(t):
    return t * lax.rsqrt(jnp.sum(t * t, axis=-1, keepdims=True) + NORM_EPS)


def chunk_gated_delta(q, k, v, g, beta):
    b_, s_, h, dk = q.shape
    dv = v.shape[-1]
    n = s_ // CHUNK

    def chunks(t):
        t = t.reshape((b_, n, CHUNK, h) + t.shape[3:])
        return jnp.moveaxis(t, (1, 3), (0, 2))

    qc, kc, vc = chunks(q), chunks(k), chunks(v)
    G = jnp.cumsum(chunks(g), axis=-1)
    bc = chunks(beta)
    idx = jnp.arange(CHUNK)
    causal = idx[:, None] >= idx[None, :]
    decay = jnp.exp(jnp.where(causal, G[..., :, None] - G[..., None, :], -jnp.inf))
    kb = kc * bc[..., None]
    m = jnp.einsum('nbhid,nbhjd->nbhij', kb, kc) * decay
    m = jnp.where(idx[:, None] > idx[None, :], m, 0.0) + jnp.eye(CHUNK, dtype=m.dtype)
    rhs = jnp.concatenate([vc * bc[..., None], kb * jnp.exp(G)[..., None]], axis=-1)
    sol = lax.linalg.triangular_solve(m, rhs, left_side=True, lower=True,
                                      unit_diagonal=True)
    u, w = sol[..., :dv], sol[..., dv:]
    qk = jnp.einsum('nbhid,nbhjd->nbhij', qc, kc) * decay
    q_dec = qc * jnp.exp(G)[..., None]
    k_dec = kc * jnp.exp(G[..., -1:] - G)[..., None]
    g_last = jnp.exp(G[..., -1])

    def step(state, inp):
        qd, kd, u_i, w_i, qk_i, gl = inp
        v_new = u_i - jnp.einsum('bhck,bhkv->bhcv', w_i, state)
        o = (jnp.einsum('bhck,bhkv->bhcv', qd, state)
             + jnp.einsum('bhij,bhjv->bhiv', qk_i, v_new))
        state = state * gl[..., None, None] + jnp.einsum('bhck,bhcv->bhkv', kd, v_new)
        return state, o

    state0 = jnp.zeros((b_, h, dk, dv), jnp.float32)
    _, o = lax.scan(step, state0, (q_dec, k_dec, u, w, qk, g_last))
    return jnp.moveaxis(o, (0, 2), (1, 3)).reshape(b_, s_, h, dv)


def gated_deltanet(q, k, v, z, b, a, conv_w, a_log, dt_bias, norm_w):
    f32 = jnp.float32
    b_, s_ = q.shape[:2]
    qkv = jax.nn.silu(causal_dwconv(jnp.concatenate([q, k, v], axis=-1), conv_w))
    q, k, v = jnp.split(qkv.astype(f32), [DN_HEADS * DN_DK, 2 * DN_HEADS * DN_DK], axis=-1)
    q = l2norm(q.reshape(b_, s_, DN_HEADS, DN_DK)) * (DN_DK ** -0.5)
    k = l2norm(k.reshape(b_, s_, DN_HEADS, DN_DK))
    v = v.reshape(b_, s_, DN_HEADS, DN_DV)
    beta = jax.nn.sigmoid(b.astype(f32))
    g = -jnp.exp(a_log.astype(f32)) * jax.nn.softplus(a.astype(f32) + dt_bias.astype(f32))
    o = chunk_gated_delta(q, k, v, g, beta)
    zf = z.reshape(b_, s_, DN_HEADS, DN_DV).astype(f32)
    o = (o * lax.rsqrt(jnp.mean(o * o, axis=-1, keepdims=True) + NORM_EPS)
         * norm_w.astype(f32) * jax.nn.silu(zf))
    return o.reshape(b_, s_, DN_HEADS * DN_DV).astype(z.dtype)


def _lin_combine(e1, e2):
    a1, b1 = e1
    a2, b2 = e2
    return a1 * a2, a2 * b1 + b2


def rglru_branch(xb, gate_in, conv_w, conv_b, gate_w, gate_b, lam):
    f32 = jnp.float32
    b_, s_ = xb.shape[:2]
    xc = (causal_dwconv(xb, conv_w) + conv_b).astype(f32)
    blk = xc.reshape(b_, s_, LRU_BLOCKS, LRU_BLK)
    gates = jnp.einsum('bsnd,gnde->gbsne', blk, gate_w.astype(f32))
    gates = gates.reshape(2, b_, s_, LRU_W) + gate_b.astype(f32)[:, None, None, :]
    r = jax.nn.sigmoid(gates[0])
    i = jax.nn.sigmoid(gates[1])
    log_a = -LRU_C * r * jax.nn.softplus(-lam.astype(f32))
    a = jnp.exp(log_a)
    u = xc * i * jnp.sqrt(-jnp.expm1(2.0 * log_a))
    _, h = lax.associative_scan(_lin_combine, (a, u), axis=1)
    return (h * jax.nn.gelu(gate_in.astype(f32))).astype(xb.dtype)


def chunk_band_attention(q, k, v, rel_table):
    b_, s_ = q.shape[:2]
    n = s_ // CHUNK
    shp = (b_, n, CHUNK, LA_HEADS, LA_HD)
    q, k, v = q.reshape(shp), k.reshape(shp), v.reshape(shp)
    pad = ((0, 0), (LA_PAST, 0), (0, 0), (0, 0), (0, 0))
    kp, vp = jnp.pad(k, pad), jnp.pad(v, pad)
    kb = jnp.concatenate([kp[:, w:w + n] for w in range(LA_PAST + 1)], axis=2)
    vb = jnp.concatenate([vp[:, w:w + n] for w in range(LA_PAST + 1)], axis=2)
    s = jnp.einsum('bnqhd,bnkhd->bhnqk', q, kb,
                   preferred_element_type=jnp.float32) * (LA_HD ** -0.5)
    qi = jnp.arange(CHUNK)[:, None]
    kj = jnp.arange(LA_BAND)[None, :]
    rel = kj - LA_PAST * CHUNK - qi
    bias = rel_table.astype(jnp.float32)[:, jnp.clip(rel, -REL_CLIP, REL_CLIP) + REL_CLIP]
    valid = (jnp.arange(n)[:, None] - LA_PAST + kj // CHUNK) >= 0
    s = jnp.where(valid[None, None, :, None, :], s + bias[None, :, None], NEG_INF)
    p = jax.nn.softmax(s, axis=-1).astype(v.dtype)
    o = jnp.einsum('bhnqk,bnkhd->bnqhd', p, vb)
    return o.reshape(b_, s_, LA_HEADS * LA_HD)


def hybrid_mixer(x, w_in, dn_conv_w, dn_a_log, dn_dt_bias, dn_norm_w, lru_conv_w,
                 lru_conv_b, lru_gate_w, lru_gate_b, lru_lambda, la_rel_bias,
                 w_branch, w_out):
    b_, s_ = x.shape[:2]
    proj = x @ w_in
    (dq, dk, dv, dz, db, da, lx, lg, aq, ak, av, gl) = jnp.split(
        proj, np.cumsum(SPLITS)[:-1].tolist(), axis=-1)
    ya = gated_deltanet(dq, dk, dv, dz, db, da, dn_conv_w, dn_a_log, dn_dt_bias, dn_norm_w)
    yb = rglru_branch(lx, lg, lru_conv_w, lru_conv_b, lru_gate_w, lru_gate_b, lru_lambda)
    yc = chunk_band_attention(aq, ak, av, la_rel_bias)
    up = jnp.einsum('bsrc,rcd->bsrd', jnp.stack([ya, yb, yc], axis=2), w_branch)
    gates = jax.nn.sigmoid(gl.astype(jnp.float32)).reshape(b_, s_, N_BRANCH, D_MODEL)
    merged = jnp.sum(gates.astype(x.dtype) * up, axis=2)
    return merged @ w_out


def memory_cross_attention(x, mem, wq, wkv, wo):
    b_, s_ = x.shape[:2]
    q = (x @ wq).reshape(b_, s_, XA_HEADS, XA_HD)
    k, v = jnp.split(mem @ wkv, 2, axis=-1)
    k = k.reshape(b_, MEM_LEN, XA_HEADS, XA_HD)
    v = v.reshape(b_, MEM_LEN, XA_HEADS, XA_HD)
    s = jnp.einsum('bshd,bmhd->bhsm', q, k,
                   preferred_element_type=jnp.float32) * (XA_HD ** -0.5)
    p = jax.nn.softmax(s, axis=-1).astype(v.dtype)
    o = jnp.einsum('bhsm,bmhd->bshd', p, v).reshape(b_, s_, D_MODEL)
    return o @ wo


def setup_inputs(seed: int = 0) -> dict:
    key = jax.random.key(seed)
    ks = jax.random.split(key, 24)
    f32 = jnp.float32

    def nrm(k, shape, fan_in, scale=1.0):
        return jax.random.normal(k, shape, f32) * (scale * fan_in ** -0.5)

    x = jax.random.normal(ks[0], (BATCH, SEQ, D_MODEL), f32)
    mem = jax.random.normal(ks[1], (BATCH, MEM_LEN, D_MODEL), f32)
    ln_g = 1.0 + 0.02 * jax.random.normal(ks[2], (DEPTH, 4, D_MODEL), f32)
    ln_b = 0.02 * jax.random.normal(ks[3], (DEPTH, 4, D_MODEL), f32)
    ffn_w12 = nrm(ks[4], (DEPTH, 2, D_MODEL, 2 * D_FF), D_MODEL)
    ffn_w3 = nrm(ks[5], (DEPTH, 2, D_FF, D_MODEL), D_FF, BETA)
    mix_w_in = nrm(ks[6], (DEPTH, D_MODEL, N_IN), D_MODEL)
    dn_conv_w = nrm(ks[7], (DEPTH, CONV_W, 2 * DN_HEADS * DN_DK + DN_HEADS * DN_DV), CONV_W)
    dn_a_log = jnp.log(jax.random.uniform(ks[8], (DEPTH, DN_HEADS), f32, 1.0, 16.0))
    dt = jnp.exp(jax.random.uniform(ks[9], (DEPTH, DN_HEADS), f32,
                                    float(np.log(1e-3)), float(np.log(1e-1))))
    dn_dt_bias = dt + jnp.log(-jnp.expm1(-dt))
    dn_norm_w = 1.0 + 0.02 * jax.random.normal(ks[10], (DEPTH, DN_DV), f32)
    lru_conv_w = nrm(ks[11], (DEPTH, CONV_W, LRU_W), CONV_W)
    lru_conv_b = 0.01 * jax.random.normal(ks[12], (DEPTH, LRU_W), f32)
    lru_gate_w = nrm(ks[13], (DEPTH, 2, LRU_BLOCKS, LRU_BLK, LRU_BLK), LRU_BLK)
    lru_gate_b = 0.01 * jax.random.normal(ks[14], (DEPTH, 2, LRU_W), f32)
    a_c = jax.random.uniform(ks[15], (DEPTH, LRU_W), f32, 0.9, 0.999)
    a0 = a_c ** (1.0 / LRU_C)
    lru_lambda = jnp.log(a0) - jnp.log1p(-a0)
    la_rel_bias = 0.1 * jax.random.normal(ks[16], (DEPTH, LA_HEADS, 2 * REL_CLIP + 1), f32)
    w_branch = nrm(ks[17], (DEPTH, N_BRANCH, BR_W, D_MODEL), BR_W)
    mix_w_out = nrm(ks[18], (DEPTH, D_MODEL, D_MODEL), D_MODEL, BETA)
    xa_wq = nrm(ks[19], (DEPTH, D_MODEL, D_MODEL), D_MODEL)
    xa_wkv = nrm(ks[20], (DEPTH, D_MODEL, 2 * D_MODEL), D_MODEL)
    xa_wo = nrm(ks[21], (DEPTH, D_MODEL, D_MODEL), D_MODEL, BETA)
    return {"x": x, "mem": mem, "ln_g": ln_g, "ln_b": ln_b, "ffn_w12": ffn_w12,
            "ffn_w3": ffn_w3, "mix_w_in": mix_w_in, "dn_conv_w": dn_conv_w,
            "dn_a_log": dn_a_log, "dn_dt_bias": dn_dt_bias, "dn_norm_w": dn_norm_w,
            "lru_conv_w": lru_conv_w, "lru_conv_b": lru_conv_b, "lru_gate_w": lru_gate_w,
            "lru_gate_b": lru_gate_b, "lru_lambda": lru_lambda, "la_rel_bias": la_rel_bias,
            "w_branch": w_branch, "mix_w_out": mix_w_out, "xa_wq": xa_wq,
            "xa_wkv": xa_wkv, "xa_wo": xa_wo}


def reference(x, mem, ln_g, ln_b, ffn_w12, ffn_w3, mix_w_in, dn_conv_w, dn_a_log,
              dn_dt_bias, dn_norm_w, lru_conv_w, lru_conv_b, lru_gate_w, lru_gate_b,
              lru_lambda, la_rel_bias, w_branch, mix_w_out, xa_wq, xa_wkv, xa_wo):
    for l in range(DEPTH):
        x = layer_norm(ALPHA * x + 0.5 * swiglu(x, ffn_w12[l, 0], ffn_w3[l, 0]),
                       ln_g[l, 0], ln_b[l, 0])
        y = hybrid_mixer(x, mix_w_in[l], dn_conv_w[l], dn_a_log[l], dn_dt_bias[l],
                         dn_norm_w[l], lru_conv_w[l], lru_conv_b[l], lru_gate_w[l],
                         lru_gate_b[l], lru_lambda[l], la_rel_bias[l], w_branch[l],
                         mix_w_out[l])
        x = layer_norm(ALPHA * x + y, ln_g[l, 1], ln_b[l, 1])
        x = layer_norm(ALPHA * x + memory_cross_attention(x, mem, xa_wq[l], xa_wkv[l], xa_wo[l]),
                       ln_g[l, 2], ln_b[l, 2])
        x = layer_norm(ALPHA * x + 0.5 * swiglu(x, ffn_w12[l, 1], ffn_w3[l, 1]),
                       ln_g[l, 3], ln_b[l, 3])
    return x
```

```cpp
#include <hip/hip_runtime.h>
#include <hip/hip_cooperative_groups.h>
#include <cstdio>
#include <cstdint>
namespace cg = cooperative_groups;

constexpr int BATCH = 2, SEQ = 8192, D = 1024, M = BATCH * SEQ, FF = 2816, NIN = 7688, DEPTH = 2;
constexpr int NCHUNK = SEQ / 64;
constexpr float ALPHA = 1.41421356237f;
constexpr float LN_EPS = 1e-5f, NORM_EPS = 1e-6f;
constexpr int NT = 512;
constexpr int LDS_BYTES = 147456;

typedef unsigned short bf16;
typedef unsigned u32x4 __attribute__((ext_vector_type(4)));
typedef float f32x4 __attribute__((ext_vector_type(4)));
#define LAS __attribute__((address_space(3)))

constexpr size_t MiB = 1u << 20;
constexpr size_t WS_W12T = 1 * MiB;
constexpr size_t WS_W3T = WS_W12T + 22 * MiB;
constexpr size_t WS_WINT = WS_W3T + 11 * MiB;
constexpr size_t WS_WBRT = WS_WINT + 15 * MiB;
constexpr size_t WS_WOUTT = WS_WBRT + 3 * MiB;
constexpr size_t WS_WQT = WS_WOUTT + 2 * MiB;
constexpr size_t WS_WOT = WS_WQT + 2 * MiB;
constexpr size_t WS_WKVT = WS_WOT + 2 * MiB;
constexpr size_t WS_XB = WS_WKVT + 4 * MiB;
constexpr size_t WS_PROJ = WS_XB + 32 * MiB;
constexpr size_t PSZ = (size_t)M * 512 * 2;
constexpr size_t WS_R2 = WS_PROJ + 9 * PSZ;
constexpr size_t WS_SMALL = WS_R2 + 104 * MiB;
constexpr size_t WS_BA = WS_SMALL;
constexpr size_t WS_KV = WS_BA + (size_t)M * 8 * 4;
constexpr size_t WS_MEMB = WS_KV + 2 * MiB;
constexpr size_t WS_END = WS_MEMB + 1 * MiB;
constexpr size_t WS_H = WS_PROJ;
constexpr size_t WS_MERGEDB = WS_PROJ + 4 * PSZ;
constexpr size_t WS_Q = WS_PROJ;
constexpr size_t WS_O = WS_PROJ + 2 * PSZ;
constexpr size_t WS_ORAW = WS_R2;
constexpr size_t WS_XC = WS_R2 + 16 * MiB;
constexpr size_t WS_LA = WS_R2 + 48 * MiB;
constexpr size_t WS_GL = WS_R2;

struct Params {
    const float *x, *mem, *ln_g, *ln_b, *ffn_w12, *ffn_w3, *mix_w_in, *dn_conv_w, *dn_a_log, *dn_dt_bias, *dn_norm_w,
        *lru_conv_w, *lru_conv_b, *lru_gate_w, *lru_gate_b, *lru_lambda, *la_rel_bias, *w_branch, *mix_w_out, *xa_wq, *xa_wkv, *xa_wo;
    float* out; unsigned char* ws;
};

__device__ __forceinline__ unsigned f2bf(float f) { unsigned u = __builtin_bit_cast(unsigned, f); return (u + 0x7fffu + ((u >> 16) & 1u)) >> 16; }
__device__ __forceinline__ unsigned pk2(float lo, float hi) { return f2bf(lo) | (f2bf(hi) << 16); }
__device__ __forceinline__ float bf2f(unsigned short b) { return __builtin_bit_cast(float, (unsigned)b << 16); }
__device__ __forceinline__ float bflo(unsigned w) { return __builtin_bit_cast(float, w << 16); }
__device__ __forceinline__ float bfhi(unsigned w) { return __builtin_bit_cast(float, w & 0xffff0000u); }
__device__ __forceinline__ float sigmoidf_(float x) { return 1.f / (1.f + __expf(-x)); }
__device__ __forceinline__ float siluf_(float x) { return x / (1.f + __expf(-x)); }
__device__ __forceinline__ float softplusf_(float x) { return x > 20.f ? x : log1pf(expf(x)); }
__device__ __forceinline__ float gelu_tanh(float x) { const float u = 0.7978845608028654f * (x + 0.044715f * x * x * x); return 0.5f * x * (1.f + tanhf(u)); }
__device__ __forceinline__ float wave_sum(float v) {
#pragma unroll
    for (int o = 1; o < 64; o <<= 1) v += __shfl_xor(v, o);
    return v;
}
__device__ __forceinline__ float wave_max(float v) {
#pragma unroll
    for (int o = 1; o < 64; o <<= 1) v = fmaxf(v, __shfl_xor(v, o));
    return v;
}
#define GTID ((int)(blockIdx.x * NT + threadIdx.x))
#define GSZ ((int)(gridDim.x * NT))
#define GWAVE ((int)(blockIdx.x * (NT / 64) + (threadIdx.x >> 6)))
#define NGWAVE ((int)(gridDim.x * (NT / 64)))

__device__ __forceinline__ int srccol(int mode, int r) {
    if (mode == 0) return r;
    if (mode == 1) { const int pn = r >> 8, bj = (r >> 7) & 1, i = r & 127; return bj * FF + 128 * pn + i; }
    if (r >= 4608) return 4616 + (r - 4608);
    const int t = r >> 9, i = r & 511;
    const int base = (t == 0) ? 0 : (t == 1) ? 512 : (t == 2) ? 1024 : (t == 3) ? 2056 : (t == 4) ? 3592 : (t == 5) ? 4104 : (t == 6) ? 1536 : (t == 7) ? 2568 : 3080;
    return base + i;
}
__device__ __forceinline__ void conv_matrix(const float* W, int ldw, int K, int Ndst, bf16* WT, int mode, LAS float* scr) {
    const int lane = threadIdx.x & 63; const int nblk = Ndst / 32, nitems = (K / 64) * nblk;
    for (int it = GWAVE; it < nitems; it += NGWAVE) {
        const int kb = it / nblk, nb = it % nblk, k0 = 64 * kb, r0 = 32 * nb, c0 = srccol(mode, r0);
#pragma unroll 8
        for (int i = 0; i < 32; ++i) { const int kk = 2 * i + (lane >> 5); scr[kk * 33 + (lane & 31)] = W[(size_t)(k0 + kk) * ldw + c0 + (lane & 31)]; }
        asm volatile("s_waitcnt lgkmcnt(0)" ::: "memory");
        const int c = lane & 7;
#pragma unroll
        for (int j = 0; j < 4; ++j) { const int n = (lane >> 3) + 8 * j; const LAS float* s = scr + (8 * c) * 33 + n;
            u32x4 o; o.x = pk2(s[0 * 33], s[1 * 33]); o.y = pk2(s[2 * 33], s[3 * 33]); o.z = pk2(s[4 * 33], s[5 * 33]); o.w = pk2(s[6 * 33], s[7 * 33]);
            *(u32x4*)(WT + (size_t)(r0 + n) * K + k0 + 8 * c) = o; }
        asm volatile("s_waitcnt lgkmcnt(0)" ::: "memory");
    }
}
__device__ __forceinline__ void phase_convert(const Params& p, int l, LAS unsigned char* lds) {
    LAS float* scr = (LAS float*)(lds + (threadIdx.x >> 6) * 16384);
    unsigned char* ws = p.ws;
    for (int f = 0; f < 2; ++f) {
        conv_matrix(p.ffn_w12 + ((size_t)l * 2 + f) * D * 2 * FF, 2 * FF, D, 2 * FF, (bf16*)(ws + WS_W12T) + (size_t)f * 2 * FF * D, 1, scr);
        conv_matrix(p.ffn_w3 + ((size_t)l * 2 + f) * FF * D, D, FF, D, (bf16*)(ws + WS_W3T) + (size_t)f * D * FF, 0, scr);
    }
    conv_matrix(p.mix_w_in + (size_t)l * D * NIN, NIN, D, 7680, (bf16*)(ws + WS_WINT), 2, scr);
    for (int r = 0; r < 3; ++r) conv_matrix(p.w_branch + ((size_t)l * 3 + r) * 512 * D, D, 512, D, (bf16*)(ws + WS_WBRT) + (size_t)r * D * 512, 0, scr);
    conv_matrix(p.mix_w_out + (size_t)l * D * D, D, D, D, (bf16*)(ws + WS_WOUTT), 0, scr);
    conv_matrix(p.xa_wq + (size_t)l * D * D, D, D, D, (bf16*)(ws + WS_WQT), 0, scr);
    conv_matrix(p.xa_wo + (size_t)l * D * D, D, D, D, (bf16*)(ws + WS_WOT), 0, scr);
    conv_matrix(p.xa_wkv + (size_t)l * D * 2 * D, 2 * D, D, 2 * D, (bf16*)(ws + WS_WKVT), 0, scr);
}
__device__ __forceinline__ void cvt_rows(const float* src, bf16* dst, size_t n) {
    for (size_t i = (size_t)GTID * 4; i < n; i += (size_t)GSZ * 4) { const f32x4 v = *(const f32x4*)(src + i); uint2 o; o.x = pk2(v.x, v.y); o.y = pk2(v.z, v.w); *(uint2*)(dst + i) = o; }
}

__device__ __forceinline__ float dot_bf16(const bf16* a, const bf16* b, int K) {
    float acc = 0.f;
    for (int k = 0; k < K; k += 8) {
        const u32x4 av = *(const u32x4*)(a + k), bv = *(const u32x4*)(b + k);
        acc += bflo(av.x) * bflo(bv.x) + bfhi(av.x) * bfhi(bv.x) + bflo(av.y) * bflo(bv.y) + bfhi(av.y) * bfhi(bv.y)
             + bflo(av.z) * bflo(bv.z) + bfhi(av.z) * bfhi(bv.z) + bflo(av.w) * bflo(bv.w) + bfhi(av.w) * bfhi(bv.w);
    }
    return acc;
}
template <class F> __device__ __forceinline__ void naive_gemm(const bf16* A, int lda, const bf16* Bt, int K, int Mr, int Nc, F f) {
    const size_t tot = (size_t)Mr * Nc;
    for (size_t idx = GTID; idx < tot; idx += GSZ) { const int r = (int)(idx / Nc), c = (int)(idx % Nc); f(r, c, dot_bf16(A + (size_t)r * lda, Bt + (size_t)c * K, K)); }
}

__device__ __forceinline__ void phase_ln(float* X, bf16* XB, const float* g, const float* b, float* BA, const float* w_in) {
    const int lane = threadIdx.x & 63;
    for (int m = GWAVE; m < M; m += NGWAVE) {
        f32x4* xr = (f32x4*)(X + (size_t)m * D) + lane;
        f32x4 v[4]; float s = 0.f;
#pragma unroll
        for (int j = 0; j < 4; ++j) { v[j] = xr[64 * j]; s += (v[j].x + v[j].y) + (v[j].z + v[j].w); }
        const float mean = wave_sum(s) * (1.f / D); float s2 = 0.f;
#pragma unroll
        for (int j = 0; j < 4; ++j) { v[j] = v[j] - mean; s2 += (v[j].x * v[j].x + v[j].y * v[j].y) + (v[j].z * v[j].z + v[j].w * v[j].w); }
        const float rstd = rsqrtf(wave_sum(s2) * (1.f / D) + LN_EPS);
#pragma unroll
        for (int j = 0; j < 4; ++j) {
            const f32x4 gg = *((const f32x4*)g + lane + 64 * j), bb = *((const f32x4*)b + lane + 64 * j);
            v[j] = v[j] * rstd * gg + bb; xr[64 * j] = v[j];
            uint2 o; o.x = pk2(v[j].x, v[j].y); o.y = pk2(v[j].z, v[j].w); *((uint2*)(XB + (size_t)m * D) + lane + 64 * j) = o;
        }
        if (BA) {
            float acc[8];
#pragma unroll
            for (int c = 0; c < 8; ++c) acc[c] = 0.f;
#pragma unroll 1
            for (int j = 0; j < 4; ++j)
#pragma unroll 1
                for (int e = 0; e < 4; ++e) {
                    const int k = 4 * lane + 256 * j + e; const float xv = v[j][e];
                    const f32x4 w0 = *(const f32x4*)(w_in + (size_t)k * NIN + 2048), w1 = *(const f32x4*)(w_in + (size_t)k * NIN + 2052);
                    acc[0] += xv * w0.x; acc[1] += xv * w0.y; acc[2] += xv * w0.z; acc[3] += xv * w0.w;
                    acc[4] += xv * w1.x; acc[5] += xv * w1.y; acc[6] += xv * w1.z; acc[7] += xv * w1.w;
                }
#pragma unroll
            for (int c = 0; c < 8; ++c) acc[c] = wave_sum(acc[c]);
            if (lane == 0) { *(f32x4*)(BA + (size_t)m * 8) = (f32x4){acc[0], acc[1], acc[2], acc[3]}; *(f32x4*)(BA + (size_t)m * 8 + 4) = (f32x4){acc[4], acc[5], acc[6], acc[7]}; }
        }
    }
}

__device__ __forceinline__ void phase_dn_naive(const Params& p, int l, LAS unsigned char* lds) {
    unsigned char* ws = p.ws;
    const bf16* DQ = (const bf16*)(ws + WS_PROJ); const bf16* DK = DQ + (size_t)M * 512; const bf16* DV = DK + (size_t)M * 512;
    const float* BA = (const float*)(ws + WS_BA); bf16* ORAW = (bf16*)(ws + WS_ORAW);
    LAS float* qs = (LAS float*)lds; LAS float* ks = qs + 128; LAS float* vs = ks + 128; LAS float* red = vs + 128;
    LAS float* part = red + 8;
    const int tid = threadIdx.x, lane = tid & 63, wv = tid >> 6;
    for (int item = blockIdx.x; item < 8; item += gridDim.x) {
        const int b = item >> 2, h = item & 3; const int d = tid & 127, kq = tid >> 7; const bool act = tid < 128;
        float S[32];
#pragma unroll
        for (int k = 0; k < 32; ++k) S[k] = 0.f;
        const float* cw = p.dn_conv_w + (size_t)l * 4 * 1536;
        float wq[4], wk[4], wvv[4];
#pragma unroll
        for (int j = 0; j < 4; ++j) { wq[j] = cw[j * 1536 + h * 128 + d]; wk[j] = cw[j * 1536 + 512 + h * 128 + d]; wvv[j] = cw[j * 1536 + 1024 + h * 128 + d]; }
        const float Aexp = expf(p.dn_a_log[l * 4 + h]), dtb = p.dn_dt_bias[l * 4 + h];
        float hq0 = 0, hq1 = 0, hq2 = 0, hk0 = 0, hk1 = 0, hk2 = 0, hv0 = 0, hv1 = 0, hv2 = 0;
        for (int t = 0; t < SEQ; ++t) {
            const size_t row = (size_t)b * SEQ + t;
            float qv = 0.f, kv = 0.f, vv = 0.f;
            if (act) {
                const float xq = bf2f(DQ[row * 512 + h * 128 + d]), xk = bf2f(DK[row * 512 + h * 128 + d]), xv = bf2f(DV[row * 512 + h * 128 + d]);
                qv = siluf_(wq[0] * hq0 + wq[1] * hq1 + wq[2] * hq2 + wq[3] * xq); hq0 = hq1; hq1 = hq2; hq2 = xq;
                kv = siluf_(wk[0] * hk0 + wk[1] * hk1 + wk[2] * hk2 + wk[3] * xk); hk0 = hk1; hk1 = hk2; hk2 = xk;
                vv = siluf_(wvv[0] * hv0 + wvv[1] * hv1 + wvv[2] * hv2 + wvv[3] * xv); hv0 = hv1; hv1 = hv2; hv2 = xv;
            }
            const float sq = wave_sum(qv * qv), sk = wave_sum(kv * kv);
            if (act && lane == 0) { red[wv * 2] = sq; red[wv * 2 + 1] = sk; }
            __syncthreads();
            const float nq = rsqrtf(red[0] + red[2] + NORM_EPS) * 0.08838834764831845f, nk = rsqrtf(red[1] + red[3] + NORM_EPS);
            if (act) { qs[d] = qv * nq; ks[d] = kv * nk; vs[d] = vv; }
            __syncthreads();
            const float beta = sigmoidf_(BA[row * 8 + h]);
            const float g = -Aexp * softplusf_(BA[row * 8 + 4 + h] + dtb); const float eg = expf(g);
            float kS = 0.f;
#pragma unroll
            for (int k = 0; k < 32; ++k) kS += ks[kq * 32 + k] * S[k];
            part[kq * 128 + d] = kS;
            __syncthreads();
            kS = (part[d] + part[128 + d]) + (part[256 + d] + part[384 + d]);
            const float coef = beta * (vs[d] - eg * kS);
            float o = 0.f;
#pragma unroll
            for (int k = 0; k < 32; ++k) { S[k] = eg * S[k] + ks[kq * 32 + k] * coef; o += qs[kq * 32 + k] * S[k]; }
            __syncthreads();
            part[kq * 128 + d] = o;
            __syncthreads();
            if (act) { o = (part[d] + part[128 + d]) + (part[256 + d] + part[384 + d]); ORAW[row * 512 + h * 128 + d] = (bf16)f2bf(o); }
        }
        __syncthreads();
    }
}
__device__ __forceinline__ void phase_dn_post(const Params& p, int l, const bf16* ORAW) {
    unsigned char* ws = p.ws; bf16* DZ = (bf16*)(ws + WS_PROJ) + (size_t)6 * M * 512;
    const int lane = threadIdx.x & 63; const float* nw = p.dn_norm_w + (size_t)l * 128;
    for (int m = GWAVE; m < M; m += NGWAVE) {
        const u32x4 ov = *((const u32x4*)(ORAW + (size_t)m * 512) + lane), zv = *((const u32x4*)(DZ + (size_t)m * 512) + lane);
        float o[8] = {bflo(ov.x), bfhi(ov.x), bflo(ov.y), bfhi(ov.y), bflo(ov.z), bfhi(ov.z), bflo(ov.w), bfhi(ov.w)};
        float z[8] = {bflo(zv.x), bfhi(zv.x), bflo(zv.y), bfhi(zv.y), bflo(zv.z), bfhi(zv.z), bflo(zv.w), bfhi(zv.w)};
        float s = 0.f;
#pragma unroll
        for (int e = 0; e < 8; ++e) s += o[e] * o[e];
        s += __shfl_xor(s, 1); s += __shfl_xor(s, 2); s += __shfl_xor(s, 4); s += __shfl_xor(s, 8);
        const float r = rsqrtf(s * (1.f / 128.f) + NORM_EPS);
        const int d0 = (lane & 15) * 8; float y[8];
#pragma unroll
        for (int e = 0; e < 8; ++e) y[e] = o[e] * r * nw[d0 + e] * siluf_(z[e]);
        u32x4 w; w.x = pk2(y[0], y[1]); w.y = pk2(y[2], y[3]); w.z = pk2(y[4], y[5]); w.w = pk2(y[6], y[7]);
        *((u32x4*)(DZ + (size_t)m * 512) + lane) = w;
    }
}

__device__ __forceinline__ void phase_lru_a1(const Params& p, int l) {
    unsigned char* ws = p.ws; const bf16* LX = (const bf16*)(ws + WS_PROJ) + (size_t)3 * M * 512; float* XC = (float*)(ws + WS_XC);
    const float* cw = p.lru_conv_w + (size_t)l * 4 * 512; const float* cb = p.lru_conv_b + (size_t)l * 512;
    for (size_t idx = GTID; idx < (size_t)M * 512; idx += GSZ) {
        const int row = (int)(idx >> 9), ch = (int)(idx & 511), t = row & (SEQ - 1);
        float acc = cb[ch];
#pragma unroll
        for (int j = 0; j < 4; ++j) { const int tt = t - 3 + j; if (tt >= 0) acc += cw[j * 512 + ch] * bf2f(LX[(size_t)(row - 3 + j) * 512 + ch]); }
        XC[idx] = acc;
    }
}
__device__ __forceinline__ void phase_lru_a2(const Params& p, int l, float* LA, float* LU) {
    unsigned char* ws = p.ws; const float* XC = (const float*)(ws + WS_XC);
    const float* gw = p.lru_gate_w + (size_t)l * 2 * 8 * 64 * 64; const float* gb = p.lru_gate_b + (size_t)l * 2 * 512; const float* lam = p.lru_lambda + (size_t)l * 512;
    for (size_t idx = GTID; idx < (size_t)M * 512; idx += GSZ) {
        const int row = (int)(idx >> 9), ch = (int)(idx & 511), n = ch >> 6, e = ch & 63;
        const float* xr = XC + (size_t)row * 512 + n * 64;
        float g0 = gb[ch], g1 = gb[512 + ch];
        for (int dd = 0; dd < 64; ++dd) { const float xv = xr[dd]; g0 += xv * gw[((size_t)(0 * 8 + n) * 64 + dd) * 64 + e]; g1 += xv * gw[((size_t)(1 * 8 + n) * 64 + dd) * 64 + e]; }
        const float r = sigmoidf_(g0), ig = sigmoidf_(g1);
        const float log_a = -8.f * r * softplusf_(-lam[ch]);
        const float a = expf(log_a);
        LA[idx] = a; LU[idx] = XC[idx] * ig * sqrtf(-expm1f(2.f * log_a));
    }
}
__device__ __forceinline__ void phase_lru_b(const Params& p, const float* LA, const float* LU) {
    unsigned char* ws = p.ws; bf16* LG = (bf16*)(ws + WS_PROJ) + (size_t)7 * M * 512;
    for (int idx = GTID; idx < BATCH * 512; idx += GSZ) {
        const int b = idx >> 9, ch = idx & 511; float h = 0.f;
        for (int t = 0; t < SEQ; ++t) { const size_t o = ((size_t)b * SEQ + t) * 512 + ch; h = LA[o] * h + LU[o]; LG[o] = (bf16)f2bf(h * gelu_tanh(bf2f(LG[o]))); }
    }
}

__device__ __forceinline__ void phase_band_naive(const Params& p, int l) {
    unsigned char* ws = p.ws; bf16* AQ = (bf16*)(ws + WS_PROJ) + (size_t)8 * M * 512; const bf16* AK = (const bf16*)(ws + WS_PROJ) + (size_t)4 * M * 512; const bf16* AV = AK + (size_t)M * 512;
    const float* tab = p.la_rel_bias + (size_t)l * 8 * 257;
    for (int idx = GTID; idx < M * 16; idx += GSZ) {
        const int row = idx >> 4, h = (idx >> 1) & 7, hd = idx & 1, b = row >> 13, t = row & (SEQ - 1), c = t >> 6;
        float o[32];
        const bf16* qp = AQ + (size_t)row * 512 + h * 64;
#pragma unroll
        for (int e = 0; e < 32; ++e) o[e] = 0.f;
        float mx = -3e38f, ls = 0.f;
        const int c0 = c - 8 < 0 ? 0 : c - 8;
        for (int kt = c0 * 64; kt < (c + 1) * 64; ++kt) {
            const size_t kr = (size_t)b * SEQ + kt;
            float s = 0.f;
#pragma unroll 2
            for (int e = 0; e < 8; ++e) { const u32x4 v = *((const u32x4*)(AK + kr * 512 + h * 64) + e); const u32x4 qq = *((const u32x4*)qp + e);
                s += bflo(qq.x) * bflo(v.x) + bfhi(qq.x) * bfhi(v.x) + bflo(qq.y) * bflo(v.y) + bfhi(qq.y) * bfhi(v.y) + bflo(qq.z) * bflo(v.z) + bfhi(qq.z) * bfhi(v.z) + bflo(qq.w) * bflo(v.w) + bfhi(qq.w) * bfhi(v.w); }
            int rel = kt - t; rel = rel < -128 ? -128 : (rel > 128 ? 128 : rel);
            s = s * 0.125f + tab[h * 257 + rel + 128];
            const float mn = fmaxf(mx, s), sc = __expf(mx - mn), pe = __expf(s - mn);
            ls = ls * sc + pe; mx = mn;
#pragma unroll
            for (int e = 0; e < 4; ++e) { const u32x4 v = *((const u32x4*)(AV + kr * 512 + h * 64 + hd * 32) + e);
                o[8 * e] = o[8 * e] * sc + pe * bflo(v.x); o[8 * e + 1] = o[8 * e + 1] * sc + pe * bfhi(v.x); o[8 * e + 2] = o[8 * e + 2] * sc + pe * bflo(v.y); o[8 * e + 3] = o[8 * e + 3] * sc + pe * bfhi(v.y);
                o[8 * e + 4] = o[8 * e + 4] * sc + pe * bflo(v.z); o[8 * e + 5] = o[8 * e + 5] * sc + pe * bfhi(v.z); o[8 * e + 6] = o[8 * e + 6] * sc + pe * bflo(v.w); o[8 * e + 7] = o[8 * e + 7] * sc + pe * bfhi(v.w); }
        }
        const float inv = 1.f / ls;
#pragma unroll
        for (int e = 0; e < 4; ++e) { u32x4 w; w.x = pk2(o[8 * e] * inv, o[8 * e + 1] * inv); w.y = pk2(o[8 * e + 2] * inv, o[8 * e + 3] * inv); w.z = pk2(o[8 * e + 4] * inv, o[8 * e + 5] * inv); w.w = pk2(o[8 * e + 6] * inv, o[8 * e + 7] * inv);
            *((u32x4*)(AQ + (size_t)row * 512 + h * 64 + hd * 32) + e) = w; }
    }
}

__device__ __forceinline__ void phase_xa_naive(const Params& p, LAS unsigned char* lds) {
    unsigned char* ws = p.ws; const bf16* Q = (const bf16*)(ws + WS_Q); const bf16* KV = (const bf16*)(ws + WS_KV); bf16* O = (bf16*)(ws + WS_O);
    const int lane = threadIdx.x & 63, wv = threadIdx.x >> 6;
    LAS float* pl = (LAS float*)lds + wv * 512;
    for (int it = GWAVE; it < M * 4; it += NGWAVE) {
        const int row = it >> 2, h = it & 3, b = row >> 13;
        { const uint2 qv = *((const uint2*)(Q + (size_t)row * D + h * 256) + lane); pl[256 + 4 * lane] = bflo(qv.x); pl[256 + 4 * lane + 1] = bfhi(qv.x); pl[256 + 4 * lane + 2] = bflo(qv.y); pl[256 + 4 * lane + 3] = bfhi(qv.y); }
        asm volatile("s_waitcnt lgkmcnt(0)" ::: "memory");
        float s[4];
#pragma unroll
        for (int j = 0; j < 4; ++j) {
            const bf16* kr = KV + (size_t)(b * 256 + lane + 64 * j) * 2048 + h * 256; float acc = 0.f;
            for (int d0 = 0; d0 < 256; d0 += 8) { const u32x4 v = *(const u32x4*)(kr + d0); const LAS float* qq = pl + 256 + d0;
                acc += qq[0] * bflo(v.x) + qq[1] * bfhi(v.x) + qq[2] * bflo(v.y) + qq[3] * bfhi(v.y) + qq[4] * bflo(v.z) + qq[5] * bfhi(v.z) + qq[6] * bflo(v.w) + qq[7] * bfhi(v.w); }
            s[j] = acc * 0.0625f;
        }
        const float mx = wave_max(fmaxf(fmaxf(s[0], s[1]), fmaxf(s[2], s[3])));
        float ls = 0.f;
#pragma unroll
        for (int j = 0; j < 4; ++j) { s[j] = __expf(s[j] - mx); ls += s[j]; }
        ls = wave_sum(ls); const float inv = 1.f / ls;
#pragma unroll
        for (int j = 0; j < 4; ++j) pl[lane + 64 * j] = s[j] * inv;
        asm volatile("s_waitcnt lgkmcnt(0)" ::: "memory");
        float o0 = 0, o1 = 0, o2 = 0, o3 = 0;
        for (int key = 0; key < 256; ++key) { const float pp = pl[key]; const uint2 v = *((const uint2*)(KV + (size_t)(b * 256 + key) * 2048 + 1024 + h * 256) + lane);
            o0 += pp * bflo(v.x); o1 += pp * bfhi(v.x); o2 += pp * bflo(v.y); o3 += pp * bfhi(v.y); }
        uint2 w; w.x = pk2(o0, o1); w.y = pk2(o2, o3); *((uint2*)(O + (size_t)row * D + h * 256) + lane) = w;
        asm volatile("s_waitcnt lgkmcnt(0)" ::: "memory");
    }
}

__global__ void __launch_bounds__(NT) fwd_megakernel(Params p) {
    extern __shared__ __attribute__((aligned(16))) unsigned char lds_raw[];
    LAS unsigned char* lds = (LAS unsigned char*)lds_raw;
    cg::grid_group grid = cg::this_grid();
    unsigned char* ws = p.ws;
    bf16* XB = (bf16*)(ws + WS_XB); float* X = p.out;
    bf16* H = (bf16*)(ws + WS_H);
    bf16* PROJ = (bf16*)(ws + WS_PROJ);
    bf16* GL = (bf16*)(ws + WS_GL);
    bf16* MERGEDB = (bf16*)(ws + WS_MERGEDB);
    bf16* Qb = (bf16*)(ws + WS_Q); bf16* Ob = (bf16*)(ws + WS_O);
    bf16* KV = (bf16*)(ws + WS_KV); bf16* MEMB = (bf16*)(ws + WS_MEMB);
    float* BA = (float*)(ws + WS_BA);
    const bf16* W12T = (const bf16*)(ws + WS_W12T); const bf16* W3T = (const bf16*)(ws + WS_W3T); const bf16* WINT = (const bf16*)(ws + WS_WINT);
    const bf16* WBRT = (const bf16*)(ws + WS_WBRT); const bf16* WOUTT = (const bf16*)(ws + WS_WOUTT); const bf16* WQT = (const bf16*)(ws + WS_WQT);
    const bf16* WOT = (const bf16*)(ws + WS_WOT); const bf16* WKVT = (const bf16*)(ws + WS_WKVT);

    phase_convert(p, 0, lds);
    cvt_rows(p.mem, MEMB, (size_t)512 * D);
    cvt_rows(p.x, XB, (size_t)M * D);
    grid.sync();

    for (int l = 0; l < DEPTH; ++l) {
        const float* lg = p.ln_g + (size_t)l * 4 * D; const float* lb = p.ln_b + (size_t)l * 4 * D;
        naive_gemm(MEMB, D, WKVT, D, 512, 2 * D, [&](int r, int c, float v) { KV[(size_t)r * 2 * D + c] = (bf16)f2bf(v); });
        for (int f = 0; f < 2; ++f) {
            if (f == 1) {
                naive_gemm(XB, D, WINT, D, M, 4608, [&](int r, int c, float v) { PROJ[(size_t)(c >> 9) * M * 512 + (size_t)r * 512 + (c & 511)] = (bf16)f2bf(v); });
                grid.sync();
#ifndef NO_DN
                phase_dn_naive(p, l, lds);
#endif
#ifndef NO_BAND
                phase_band_naive(p, l);
#endif
                phase_lru_a1(p, l);
                grid.sync();
                phase_dn_post(p, l, (const bf16*)(ws + WS_ORAW));
                phase_lru_a2(p, l, (float*)(ws + WS_LA), (float*)(ws + WS_XC));
                grid.sync();
                phase_lru_b(p, (const float*)(ws + WS_LA), (const float*)(ws + WS_XC));
                grid.sync();
                naive_gemm(XB, D, WINT + (size_t)4608 * D, D, M, 3072, [&](int r, int c, float v) { GL[(size_t)r * 3072 + c] = (bf16)f2bf(v); });
                grid.sync();
                {
                    const bf16* Y = PROJ + (size_t)6 * M * 512;
                    const size_t tot = (size_t)M * D;
                    for (size_t idx = GTID; idx < tot; idx += GSZ) { const int r = (int)(idx >> 10), c = (int)(idx & 1023); float acc = 0.f;
                        for (int br = 0; br < 3; ++br) acc += sigmoidf_(bf2f(GL[(size_t)r * 3072 + br * 1024 + c])) * dot_bf16(Y + (size_t)br * M * 512 + (size_t)r * 512, WBRT + ((size_t)br * D + c) * 512, 512);
                        MERGEDB[idx] = (bf16)f2bf(acc); }
                }
                grid.sync();
                naive_gemm(MERGEDB, D, WOUTT, D, M, D, [&](int r, int c, float v) { const size_t o = (size_t)r * D + c; X[o] = ALPHA * X[o] + v; });
                grid.sync();
                phase_ln(X, XB, lg + 1 * D, lb + 1 * D, nullptr, nullptr);
                grid.sync();
                naive_gemm(XB, D, WQT, D, M, D, [&](int r, int c, float v) { Qb[(size_t)r * D + c] = (bf16)f2bf(v); });
                grid.sync();
#ifndef NO_XA
                phase_xa_naive(p, lds);
#endif
                grid.sync();
                naive_gemm(Ob, D, WOT, D, M, D, [&](int r, int c, float v) { const size_t o = (size_t)r * D + c; X[o] = ALPHA * X[o] + v; });
                grid.sync();
                phase_ln(X, XB, lg + 2 * D, lb + 2 * D, nullptr, nullptr);
                grid.sync();
            }
            {
                const bf16* Wt = W12T + (size_t)f * 2 * FF * D;
                const size_t tot = (size_t)M * FF;
                for (size_t idx = GTID; idx < tot; idx += GSZ) { const int r = (int)(idx / FF), c = (int)(idx % FF); const int rho = 256 * (c >> 7) + (c & 127);
                    const float g = dot_bf16(XB + (size_t)r * D, Wt + (size_t)rho * D, D), u = dot_bf16(XB + (size_t)r * D, Wt + (size_t)(rho + 128) * D, D);
                    H[idx] = (bf16)f2bf(siluf_(g) * u); }
            }
            grid.sync();
            {
                const float* Xsrc = (l == 0 && f == 0) ? p.x : X;
                naive_gemm(H, FF, W3T + (size_t)f * D * FF, FF, M, D, [&](int r, int c, float v) { const size_t o = (size_t)r * D + c; X[o] = ALPHA * Xsrc[o] + 0.5f * v; });
            }
            grid.sync();
            if (f == 0) phase_ln(X, XB, lg, lb, BA, p.mix_w_in + (size_t)l * D * NIN);
            else { phase_ln(X, XB, lg + 3 * D, lb + 3 * D, nullptr, nullptr); if (l + 1 < DEPTH) phase_convert(p, l + 1, lds); }
            grid.sync();
        }
    }
}

extern "C" void kernel_launch(void* const* d_in, const int* in_sizes, int n_in, void* d_out, int out_size, void* d_ws, size_t ws_size, hipStream_t stream) {
    static int grid_blocks = 0;
    if (grid_blocks == 0) {
        if (n_in != 22 || ws_size < WS_END) { fprintf(stderr, "kernel_launch: unexpected n_in %d or ws_size %zu (< %zu)\n", n_in, ws_size, (size_t)WS_END); grid_blocks = -1; return; }
        int dev = 0, cus = 0, per_cu = 0;
        hipGetDevice(&dev);
        hipDeviceGetAttribute(&cus, hipDeviceAttributeMultiprocessorCount, dev);
        hipFuncSetAttribute((const void*)fwd_megakernel, hipFuncAttributeMaxDynamicSharedMemorySize, LDS_BYTES);
        hipOccupancyMaxActiveBlocksPerMultiprocessor(&per_cu, (const void*)fwd_megakernel, NT, LDS_BYTES);
        if (per_cu < 1) per_cu = 1;
        grid_blocks = cus * per_cu;
    }
    if (grid_blocks < 0) return;
    Params p{};
    const float** pp = (const float**)&p;
    for (int i = 0; i < 22; ++i) pp[i] = (const float*)d_in[i];
    p.out = (float*)d_out; p.ws = (unsigned char*)d_ws;
    void* args[] = {&p};
    hipError_t e = hipLaunchCooperativeKernel((const void*)fwd_megakernel, dim3(grid_blocks), dim3(NT), args, LDS_BYTES, stream);
    if (e != hipSuccess) fprintf(stderr, "cooperative launch failed: %s (grid %d)\n", hipGetErrorString(e), grid_blocks);
}
```

```cpp
#include <hip/hip_runtime.h>
#include <hip/hip_cooperative_groups.h>
#include <cstdio>
#include <cstdint>
namespace cg = cooperative_groups;

namespace pg8 {
#define PG8_LAS __attribute__((address_space(3)))
typedef unsigned short bf16_t;
typedef short bf16x8 __attribute__((ext_vector_type(8)));
typedef float f32x4 __attribute__((ext_vector_type(4)));
typedef unsigned u32x4 __attribute__((ext_vector_type(4)));
constexpr int BM = 256, BK = 64, HALF = 128, HTB = HALF * BK * 2  , STAGE_BYTES = 8 * HTB, NXCD = 8, WGM = 8;

__host__ __device__ __forceinline__ int lds_byte(int r, int c) { const int st = (r >> 4) * 2 + (c >> 5), rr = r & 15, cc = c & 31, ob = rr * 64 + cc * 2; return st * 1024 + (ob ^ (((ob >> 9) & 1) << 5)); }
__host__ __device__ __forceinline__ void stage_rc(int b, int& R, int& C) { const int st = b / 1024, sb = b % 1024, swz = sb ^ (((sb >> 9) & 1) << 5); R = (st >> 1) * 16 + swz / 64; C = (st & 1) * 32 + (swz % 64) / 2; }
__host__ __device__ __forceinline__ int perm32(int rho) { const int n = rho >> 4, i = rho & 15; return 8 * (i >> 2) + 4 * n + (i & 3); }

struct Unit { int pm, pn; };
struct Gemm { const bf16_t* A; const bf16_t* Bt; int M, N, K; };

struct StaticOrder {
    int nM, nN, nwg, G, c;
    __host__ __device__ void init(int M, int N, int G_, int c_) { nM = M / BM; nN = N / BM; nwg = nM * nN; G = G_; c = c_; }
    __host__ __device__ bool next(int i, Unit& u) const {
        const long L = (long)i * G + c; if (L >= nwg) return false;
        int wgid = (int)L; { const int q = nwg / NXCD, r = nwg % NXCD, xcd = wgid % NXCD, off = wgid / NXCD; wgid = (xcd < r ? xcd * (q + 1) : r * (q + 1) + (xcd - r) * q) + off; }
        const int nig = WGM * nN, gid = wgid / nig, fm = gid * WGM, gsz = (nM - fm) < WGM ? (nM - fm) : WGM;
        u.pm = fm + ((wgid % nig) % gsz); u.pn = (wgid % nig) / gsz; return true;
    }
    __device__ __forceinline__ void a_ready(const Unit&) const {}
    __device__ __forceinline__ void done(const Unit&) const {}
};
__device__ __forceinline__ unsigned cvt_pk_bf16(float lo, float hi) { unsigned r; asm volatile("v_cvt_pk_bf16_f32 %0, %1, %2" : "=v"(r) : "v"(lo), "v"(hi)); return r; }
typedef float f32x2 __attribute__((ext_vector_type(2)));
__device__ __forceinline__ f32x2 gelu_pk(f32x2 v) {
    const f32x2 av = __builtin_elementwise_abs(v), d = av * 0.2316418882f + 1.0f;
    f32x2 t; t.x = __builtin_amdgcn_rcpf(d.x); t.y = __builtin_amdgcn_rcpf(d.y);
    f32x2 q = t * 0.5307027145f + (-0.7265760135f); q = q * t + 0.7107068705f; q = q * t + (-0.142248368f); q = q * t + 0.127414796f; q = q * t;
    const f32x2 s = (v * v) * (-0.72134752044f);
    f32x2 e; e.x = __builtin_amdgcn_exp2f(s.x); e.y = __builtin_amdgcn_exp2f(s.y);
    const f32x2 m = v * (q * e), r = v - m;
    f32x2 o; o.x = v.x < 0.f ? m.x : r.x; o.y = v.y < 0.f ? m.y : r.y; return o;
}

template <int ACT  > struct EpiBf16 {
    static constexpr bool PERM = true, AFTER_DRAIN = false; static_assert(ACT == 0 || ACT == 1, "EpiBf16: ACT is 0 (none) or 1 (gelu_pk)");
    bf16_t* O; int ldc; const float* bias; int split_cols; size_t split_stride; float scale0;
    __device__ __forceinline__ void operator()(const f32x4 (&acc)[2][2][4][2], const Unit& u, int wr, int wc, int fr, int fq) const {
        const int row0 = u.pm * BM + wr * 64 + fr; int colt = u.pn * BM; bf16_t* base = O;
        float sc = 1.f; if (split_cols) { const int t = colt / split_cols; base += (size_t)t * split_stride; colt -= t * split_cols; if (t == 0) sc = scale0; }
        const int col0 = colt + wc * 32 + 8 * fq, bcol0 = u.pn * BM + wc * 32 + 8 * fq;
        f32x4 bv[2][2];
#pragma unroll
        for (int bj = 0; bj < 2; ++bj)
#pragma unroll
            for (int n = 0; n < 2; ++n) bv[bj][n] = bias ? *(const f32x4*)(bias + bcol0 + bj * HALF + 4 * n) : (f32x4){0.f, 0.f, 0.f, 0.f};
#pragma unroll
        for (int ai = 0; ai < 2; ++ai)
#pragma unroll
            for (int m = 0; m < 4; ++m) { bf16_t* rowp = base + (size_t)(row0 + ai * HALF + m * 16) * ldc + col0;
#pragma unroll
                for (int bj = 0; bj < 2; ++bj) { f32x4 v0 = acc[ai][bj][m][0] + bv[bj][0], v1 = acc[ai][bj][m][1] + bv[bj][1];
                    if (ACT == 1) { f32x2 a = gelu_pk((f32x2){v0[0], v0[1]}), b = gelu_pk((f32x2){v0[2], v0[3]}), c = gelu_pk((f32x2){v1[0], v1[1]}), d = gelu_pk((f32x2){v1[2], v1[3]});
                        v0 = (f32x4){a.x, a.y, b.x, b.y}; v1 = (f32x4){c.x, c.y, d.x, d.y}; }
                    v0 = v0 * sc; v1 = v1 * sc; u32x4 w; w.x = cvt_pk_bf16(v0[0], v0[1]); w.y = cvt_pk_bf16(v0[2], v0[3]); w.z = cvt_pk_bf16(v1[0], v1[1]); w.w = cvt_pk_bf16(v1[2], v1[3]);
                    *(u32x4*)(rowp + bj * HALF) = w; } }
    }
};
struct EpiSwiglu {
    static constexpr bool PERM = true, AFTER_DRAIN = false;
    bf16_t* H; int ldh;
    __device__ __forceinline__ void operator()(const f32x4 (&acc)[2][2][4][2], const Unit& u, int wr, int wc, int fr, int fq) const {
        const int row0 = u.pm * BM + wr * 64 + fr, col0 = u.pn * 128 + wc * 32 + 8 * fq;
#pragma unroll
        for (int ai = 0; ai < 2; ++ai)
#pragma unroll
            for (int m = 0; m < 4; ++m) {
                float h[8];
#pragma unroll
                for (int n = 0; n < 2; ++n)
#pragma unroll
                    for (int j = 0; j < 4; ++j) { const float g = acc[ai][0][m][n][j], uu = acc[ai][1][m][n][j]; h[4 * n + j] = g / (1.f + __expf(-g)) * uu; }
                u32x4 w; w.x = cvt_pk_bf16(h[0], h[1]); w.y = cvt_pk_bf16(h[2], h[3]); w.z = cvt_pk_bf16(h[4], h[5]); w.w = cvt_pk_bf16(h[6], h[7]);
                *(u32x4*)(H + (size_t)(row0 + ai * HALF + m * 16) * ldh + col0) = w;
            }
    }
};
struct EpiResid {
    static constexpr bool PERM = true, AFTER_DRAIN = false;
    const float* Xsrc; float* Xdst; float alpha, s;
    __device__ __forceinline__ void operator()(const f32x4 (&acc)[2][2][4][2], const Unit& u, int wr, int wc, int fr, int fq) const {
        const int row0 = u.pm * BM + wr * 64 + fr, col0 = u.pn * BM + wc * 32 + 8 * fq;
#pragma unroll
        for (int ai = 0; ai < 2; ++ai)
#pragma unroll
            for (int m = 0; m < 4; ++m)
#pragma unroll
                for (int bj = 0; bj < 2; ++bj) {
                    const size_t o = (size_t)(row0 + ai * HALF + m * 16) * 1024 + col0 + bj * HALF;
                    const f32x4 x0 = *(const f32x4*)(Xsrc + o), x1 = *(const f32x4*)(Xsrc + o + 4);
                    *(f32x4*)(Xdst + o) = x0 * alpha + acc[ai][bj][m][0] * s; *(f32x4*)(Xdst + o + 4) = x1 * alpha + acc[ai][bj][m][1] * s;
                }
    }
};
struct EpiBranch {
    static constexpr bool PERM = true, AFTER_DRAIN = false;
    const bf16_t* GL; float* MERGED; bf16_t* MERGEDB;
    __device__ __forceinline__ void operator()(const f32x4 (&acc)[2][2][4][2], const Unit& u, int wr, int wc, int fr, int fq) const {
        const int r = u.pm >> 6, pm = u.pm & 63, pn = u.pn & 3;
        const int row0 = pm * BM + wr * 64 + fr, col0 = pn * BM + wc * 32 + 8 * fq;
#pragma unroll
        for (int ai = 0; ai < 2; ++ai)
#pragma unroll
            for (int m = 0; m < 4; ++m)
#pragma unroll
                for (int bj = 0; bj < 2; ++bj) {
                    const int row = row0 + ai * HALF + m * 16, col = col0 + bj * HALF;
                    const u32x4 gv = *(const u32x4*)(GL + (size_t)row * 3072 + r * 1024 + col);
                    float g[8] = {__builtin_bit_cast(float, gv.x << 16), __builtin_bit_cast(float, gv.x & 0xffff0000u), __builtin_bit_cast(float, gv.y << 16), __builtin_bit_cast(float, gv.y & 0xffff0000u),
                                  __builtin_bit_cast(float, gv.z << 16), __builtin_bit_cast(float, gv.z & 0xffff0000u), __builtin_bit_cast(float, gv.w << 16), __builtin_bit_cast(float, gv.w & 0xffff0000u)};
                    float v[8];
#pragma unroll
                    for (int e = 0; e < 8; ++e) v[e] = acc[ai][bj][m][e >> 2][e & 3] / (1.f + __expf(-g[e]));
                    const size_t o = (size_t)row * 1024 + col;
                    if (r > 0) { const f32x4 p0 = *(const f32x4*)(MERGED + o), p1 = *(const f32x4*)(MERGED + o + 4);
                        v[0] += p0.x; v[1] += p0.y; v[2] += p0.z; v[3] += p0.w; v[4] += p1.x; v[5] += p1.y; v[6] += p1.z; v[7] += p1.w; }
                    if (r < 2) { *(f32x4*)(MERGED + o) = (f32x4){v[0], v[1], v[2], v[3]}; *(f32x4*)(MERGED + o + 4) = (f32x4){v[4], v[5], v[6], v[7]}; }
                    else { u32x4 w; w.x = cvt_pk_bf16(v[0], v[1]); w.y = cvt_pk_bf16(v[2], v[3]); w.z = cvt_pk_bf16(v[4], v[5]); w.w = cvt_pk_bf16(v[6], v[7]); *(u32x4*)(MERGEDB + o) = w; }
                }
    }
};
struct BranchOrder {
    StaticOrder S0;
    __host__ __device__ void init(int G_, int c_) { S0.init(16384, 1024, G_, c_); }
    __host__ __device__ bool next(int i, Unit& u) const { Unit b; if (!S0.next(i / 3, b)) return false; const int r = i % 3; u.pm = 64 * r + b.pm; u.pn = 4 * r + b.pn; return true; }
    __device__ __forceinline__ void a_ready(const Unit&) const {}
    __device__ __forceinline__ void done(const Unit&) const {}
};
template <class Epi, class Sched, bool ALIGN_EPI = false, bool SP2 = false>
__device__ __forceinline__ void gemm_phase(PG8_LAS unsigned char* lds, const Gemm g, const Sched& S, const Epi& E) {
    int tid_ = threadIdx.x; asm volatile("" : "+v"(tid_));
    const int tid = tid_, wid = __builtin_amdgcn_readfirstlane(tid >> 6), lane = tid & 63, wr = wid >> 2, wc = wid & 3, fr = lane & 15, fq = lane >> 4;
    const int K = g.K, nt = K / BK;
    unsigned voffA[2], voffB[2];
#pragma unroll
    for (int i = 0; i < 2; ++i) { int R, C; stage_rc(tid * 16 + i * 8192, R, C); const int Rb = Epi::PERM ? ((R & ~31) + perm32(R & 31)) : R;
        voffA[i] = (unsigned)(R * K + C) * 2u; voffB[i] = (unsigned)(Rb * K + C) * 2u; }
    const size_t kstep = (size_t)(BK * 2);
    const size_t hstep = (size_t)HALF * K * 2;
    const size_t tstep = 2 * hstep;
    const unsigned ldsw = (unsigned)wid * 1024u;
    const int aoff = lds_byte(wr * 64 + fr, fq * 8), boff = lds_byte(wc * 32 + fr, fq * 8);
#define PG8_SA(b, h) (((b) * 2 + (h)) * HTB)
#define PG8_SB(b, h) ((4 + (b) * 2 + (h)) * HTB)
#define PG8_STAGE(bufoff, gbase, voff) do { _Pragma("unroll") for (int _i = 0; _i < 2; ++_i) \
        __builtin_amdgcn_global_load_lds((const unsigned*)((const char*)(gbase) + (voff)[_i]), (PG8_LAS unsigned*)(lds + (bufoff) + ldsw + _i * 8192), 16, 0, 0); } while (0)
#define PG8_LDA(dst, b, h) do { _Pragma("unroll") for (int m = 0; m < 4; ++m) _Pragma("unroll") for (int k = 0; k < 2; ++k) dst[m][k] = *(const PG8_LAS bf16x8*)(lds + PG8_SA(b, h) + aoff + m * 2048 + k * 1024); } while (0)
#define PG8_LDB(dst, b, h) do { _Pragma("unroll") for (int n = 0; n < 2; ++n) _Pragma("unroll") for (int k = 0; k < 2; ++k) dst[n][k] = *(const PG8_LAS bf16x8*)(lds + PG8_SB(b, h) + boff + n * 2048 + k * 1024); } while (0)
#define PG8_MMA(ai, bj, At, Bt) do { __builtin_amdgcn_s_setprio(1); _Pragma("unroll") for (int m = 0; m < 4; ++m) _Pragma("unroll") for (int n = 0; n < 2; ++n) _Pragma("unroll") for (int k = 0; k < 2; ++k) \
        acc[ai][bj][m][n] = __builtin_amdgcn_mfma_f32_16x16x32_bf16(Bt[n][k], At[m][k], acc[ai][bj][m][n], 0, 0, 0); __builtin_amdgcn_s_setprio(0); } while (0)
#define PG8_WAIT_V(n) asm volatile("s_waitcnt vmcnt(" #n ")" ::: "memory")
#define PG8_WAIT_L(n) asm volatile("s_waitcnt lgkmcnt(" #n ")" ::: "memory")
#define PG8_BAR __builtin_amdgcn_s_barrier()
#define PG8_SCHED __builtin_amdgcn_sched_barrier(0)
    Unit cur, nxt; int ui = 0;
    if (!S.next(0, cur)) return;
    f32x4 acc[2][2][4][2];
#pragma unroll
    for (int a = 0; a < 2; ++a)
#pragma unroll
        for (int b = 0; b < 2; ++b)
#pragma unroll
            for (int m = 0; m < 4; ++m)
#pragma unroll
                for (int n = 0; n < 2; ++n) acc[a][b][m][n] = (f32x4){0.f, 0.f, 0.f, 0.f};
    bf16x8 At[4][2], B0[2][2], B1[2][2];
    const char* cA = (const char*)g.A + (size_t)cur.pm * tstep; const char* cB = (const char*)g.Bt + (size_t)cur.pn * tstep;
    S.a_ready(cur);
    if constexpr (SP2) {
        PG8_STAGE(PG8_SB(0, 0), cB, voffB); PG8_STAGE(PG8_SB(0, 1), cB + hstep, voffB); PG8_STAGE(PG8_SA(0, 0), cA, voffA); PG8_STAGE(PG8_SA(0, 1), cA + hstep, voffA);
        if (wr == 1) PG8_BAR;
        PG8_WAIT_V(2); PG8_BAR;
        PG8_STAGE(PG8_SB(1, 0), cB + kstep, voffB); PG8_STAGE(PG8_SA(1, 0), cA + kstep, voffA); PG8_STAGE(PG8_SB(1, 1), cB + hstep + kstep, voffB);
        PG8_WAIT_V(6); PG8_BAR;
    } else {
        PG8_STAGE(PG8_SB(0, 0), cB, voffB); PG8_STAGE(PG8_SA(0, 0), cA, voffA); PG8_STAGE(PG8_SB(0, 1), cB + hstep, voffB); PG8_STAGE(PG8_SA(0, 1), cA + hstep, voffA);
        if (wr == 1) PG8_BAR;
        PG8_WAIT_V(4); PG8_BAR;
        PG8_STAGE(PG8_SB(1, 0), cB + kstep, voffB); PG8_STAGE(PG8_SA(1, 0), cA + kstep, voffA); PG8_STAGE(PG8_SB(1, 1), cB + hstep + kstep, voffB);
        PG8_WAIT_V(6); PG8_BAR;
    }
    for (;;) {
        const bool has_next = S.next(ui + 1, nxt);
        const char* nA = has_next ? (const char*)g.A + (size_t)nxt.pm * tstep : cA; const char* nB = has_next ? (const char*)g.Bt + (size_t)nxt.pn * tstep : cB;
        for (int t = 0; t < nt; t += 2) {
            const bool last = (t == nt - 2);
            const char* a1 = cA + (size_t)(t + 1) * kstep;
            const char* a2 = last ? nA : cA + (size_t)(t + 2) * kstep; const char* b2 = last ? nB : cB + (size_t)(t + 2) * kstep;
            const char* a3 = a2 + kstep; const char* b3 = b2 + kstep;
            if (last && has_next) S.a_ready(nxt);
            if constexpr (SP2) {
            PG8_LDB(B0, 0, 0); PG8_LDB(B1, 0, 1); PG8_SCHED; PG8_LDA(At, 0, 0); PG8_STAGE(PG8_SA(1, 1), a1 + hstep, voffA);
            PG8_WAIT_V(8); PG8_WAIT_L(0); PG8_BAR; PG8_MMA(0, 0, At, B0); PG8_MMA(0, 1, At, B1); PG8_BAR; PG8_SCHED;
            PG8_LDA(At, 0, 1); PG8_STAGE(PG8_SB(0, 0), b2, voffB); PG8_STAGE(PG8_SB(0, 1), b2 + hstep, voffB); PG8_STAGE(PG8_SA(0, 0), a2, voffA);
            PG8_WAIT_V(8); PG8_WAIT_L(0); PG8_BAR; PG8_MMA(1, 0, At, B0); PG8_MMA(1, 1, At, B1); PG8_BAR; PG8_SCHED;
            PG8_LDB(B0, 1, 0); PG8_LDB(B1, 1, 1); PG8_SCHED; PG8_LDA(At, 1, 0); PG8_STAGE(PG8_SA(0, 1), a2 + hstep, voffA);
            PG8_WAIT_V(8); PG8_WAIT_L(0); PG8_BAR; PG8_MMA(0, 0, At, B0); PG8_MMA(0, 1, At, B1); PG8_BAR; PG8_SCHED;
            PG8_LDA(At, 1, 1); PG8_STAGE(PG8_SB(1, 0), b3, voffB); PG8_STAGE(PG8_SB(1, 1), b3 + hstep, voffB); PG8_STAGE(PG8_SA(1, 0), a3, voffA);
            PG8_WAIT_V(8); PG8_WAIT_L(0); PG8_BAR; PG8_MMA(1, 0, At, B0); PG8_MMA(1, 1, At, B1); PG8_BAR; PG8_SCHED;
            } else {
            PG8_LDB(B0, 0, 0); PG8_SCHED; PG8_LDA(At, 0, 0); PG8_STAGE(PG8_SA(1, 1), a1 + hstep, voffA);
            PG8_WAIT_L(8); PG8_BAR; PG8_WAIT_L(0); PG8_MMA(0, 0, At, B0); PG8_BAR; PG8_SCHED;
            PG8_LDB(B1, 0, 1); PG8_STAGE(PG8_SB(0, 0), b2, voffB);
            PG8_BAR; PG8_WAIT_L(0); PG8_MMA(0, 1, At, B1); PG8_BAR;
            PG8_LDA(At, 0, 1); PG8_STAGE(PG8_SA(0, 0), a2, voffA);
            PG8_BAR; PG8_WAIT_L(0); PG8_MMA(1, 0, At, B0); PG8_BAR; PG8_SCHED;
            PG8_STAGE(PG8_SB(0, 1), b2 + hstep, voffB);
            PG8_WAIT_V(6); PG8_BAR; PG8_MMA(1, 1, At, B1); PG8_BAR;
            PG8_LDB(B0, 1, 0); PG8_SCHED; PG8_LDA(At, 1, 0); PG8_STAGE(PG8_SA(0, 1), a2 + hstep, voffA);
            PG8_WAIT_L(8); PG8_BAR; PG8_WAIT_L(0); PG8_MMA(0, 0, At, B0); PG8_BAR; PG8_SCHED;
            PG8_LDB(B1, 1, 1); PG8_STAGE(PG8_SB(1, 0), b3, voffB);
            PG8_BAR; PG8_WAIT_L(0); PG8_MMA(0, 1, At, B1); PG8_BAR;
            PG8_LDA(At, 1, 1); PG8_STAGE(PG8_SA(1, 0), a3, voffA);
            PG8_BAR; PG8_WAIT_L(0); PG8_MMA(1, 0, At, B0); PG8_BAR; PG8_SCHED;
            PG8_STAGE(PG8_SB(1, 1), b3 + hstep, voffB);
            PG8_WAIT_V(6); PG8_BAR; PG8_MMA(1, 1, At, B1); PG8_BAR;
            }
        }
        if constexpr (ALIGN_EPI) { if (wr == 0) PG8_BAR; }
        if constexpr (!Epi::AFTER_DRAIN) { E(acc, cur, wr, wc, fr, fq); S.done(cur); }
        if (!has_next) break;
#pragma unroll
        for (int a = 0; a < 2; ++a)
#pragma unroll
            for (int b = 0; b < 2; ++b)
#pragma unroll
                for (int m = 0; m < 4; ++m)
#pragma unroll
                    for (int n = 0; n < 2; ++n) acc[a][b][m][n] = (f32x4){0.f, 0.f, 0.f, 0.f};
        cur = nxt; cA = nA; cB = nB; ++ui;
        if constexpr (ALIGN_EPI) { if (wr == 1) PG8_BAR; }
    }
    PG8_WAIT_V(0);
    if constexpr (!ALIGN_EPI) { if (wr == 0) PG8_BAR; }
    PG8_BAR;
    if constexpr (Epi::AFTER_DRAIN) { E.fused(acc, cur, wr, wc, fr, fq, lds, wid, lane); S.done(cur); }
#undef PG8_SA
#undef PG8_SB
#undef PG8_STAGE
#undef PG8_LDA
#undef PG8_LDB
#undef PG8_MMA
#undef PG8_WAIT_V
#undef PG8_WAIT_L
#undef PG8_BAR
#undef PG8_SCHED
}
}

constexpr int BATCH = 2, SEQ = 8192, D = 1024, M = BATCH * SEQ, FF = 2816, NIN = 7688, DEPTH = 2;
constexpr int NCHUNK = SEQ / 64;
constexpr float ALPHA = 1.41421356237f;
constexpr float LN_EPS = 1e-5f, NORM_EPS = 1e-6f;
constexpr int NT = 512;
constexpr int LDS_BYTES = 147456;

typedef unsigned short bf16;
typedef unsigned u32x4 __attribute__((ext_vector_type(4)));
typedef float f32x4 __attribute__((ext_vector_type(4)));
typedef unsigned u32x2 __attribute__((ext_vector_type(2)));
#define LAS __attribute__((address_space(3)))

constexpr size_t MiB = 1u << 20;
constexpr size_t WS_W12T = 1 * MiB;
constexpr size_t WS_W3T = WS_W12T + 22 * MiB;
constexpr size_t WS_WINT = WS_W3T + 11 * MiB;
constexpr size_t WS_WBRT = WS_WINT + 15 * MiB;
constexpr size_t WS_WOUTT = WS_WBRT + 3 * MiB;
constexpr size_t WS_WQT = WS_WOUTT + 2 * MiB;
constexpr size_t WS_WOT = WS_WQT + 2 * MiB;
constexpr size_t WS_WKVT = WS_WOT + 2 * MiB;
constexpr size_t WS_XB = WS_WKVT + 4 * MiB;
constexpr size_t WS_PROJ = WS_XB + 32 * MiB;
constexpr size_t PSZ = (size_t)M * 512 * 2;
constexpr size_t WS_R2 = WS_PROJ + 9 * PSZ;
constexpr size_t WS_SMALL = WS_R2 + 104 * MiB;
constexpr size_t WS_BA = WS_SMALL;
constexpr size_t WS_KV = WS_BA + (size_t)M * 8 * 4;
constexpr size_t WS_MEMB = WS_KV + 2 * MiB;
constexpr size_t WS_GLAST = WS_MEMB + 1 * MiB;
constexpr size_t WS_LRUPE = WS_GLAST + 4096;
constexpr size_t WS_VT = WS_LRUPE + 1 * MiB;
constexpr size_t WS_END = WS_VT + 1 * MiB;
constexpr size_t WS_H = WS_PROJ;
constexpr size_t WS_MERGEDB = WS_PROJ + 4 * PSZ;
constexpr size_t WS_Q = WS_PROJ;
constexpr size_t WS_O = WS_PROJ + 2 * PSZ;
constexpr size_t WS_ORAW = WS_R2;
constexpr size_t WS_XC = WS_R2 + 16 * MiB;
constexpr size_t WS_LA = WS_R2 + 48 * MiB;
constexpr size_t WS_GL = WS_R2;

struct Params {
    const float *x, *mem, *ln_g, *ln_b, *ffn_w12, *ffn_w3, *mix_w_in, *dn_conv_w, *dn_a_log, *dn_dt_bias, *dn_norm_w,
        *lru_conv_w, *lru_conv_b, *lru_gate_w, *lru_gate_b, *lru_lambda, *la_rel_bias, *w_branch, *mix_w_out, *xa_wq, *xa_wkv, *xa_wo;
    float* out; unsigned char* ws;
};

__device__ __forceinline__ unsigned f2bf(float f) { unsigned u = __builtin_bit_cast(unsigned, f); return (u + 0x7fffu + ((u >> 16) & 1u)) >> 16; }
__device__ __forceinline__ unsigned pk2(float lo, float hi) { return f2bf(lo) | (f2bf(hi) << 16); }
__device__ __forceinline__ float bf2f(unsigned short b) { return __builtin_bit_cast(float, (unsigned)b << 16); }
__device__ __forceinline__ float bflo(unsigned w) { return __builtin_bit_cast(float, w << 16); }
__device__ __forceinline__ float bfhi(unsigned w) { return __builtin_bit_cast(float, w & 0xffff0000u); }
__device__ __forceinline__ float sigmoidf_(float x) { return 1.f / (1.f + __expf(-x)); }
__device__ __forceinline__ float siluf_(float x) { return x / (1.f + __expf(-x)); }
__device__ __forceinline__ float softplusf_(float x) { return x > 20.f ? x : log1pf(expf(x)); }
__device__ __forceinline__ float gelu_tanh(float x) { const float u = 0.7978845608028654f * (x + 0.044715f * x * x * x); return 0.5f * x * (1.f + tanhf(u)); }
__device__ __forceinline__ float wave_sum(float v) {
#pragma unroll
    for (int o = 1; o < 64; o <<= 1) v += __shfl_xor(v, o);
    return v;
}
__device__ __forceinline__ float wave_max(float v) {
#pragma unroll
    for (int o = 1; o < 64; o <<= 1) v = fmaxf(v, __shfl_xor(v, o));
    return v;
}
__device__ __forceinline__ int ltid() { int t = threadIdx.x; asm volatile("" : "+v"(t)); return t; }
#define GTID ((int)(blockIdx.x * NT + ltid()))
#define GSZ ((int)(gridDim.x * NT))
#define GWAVE ((int)(blockIdx.x * (NT / 64) + (ltid() >> 6)))
#define NGWAVE ((int)(gridDim.x * (NT / 64)))

__device__ __forceinline__ int srccol(int mode, int r) {
    if (mode == 0) return r;
    if (mode == 1) { const int pn = r >> 8, bj = (r >> 7) & 1, i = r & 127; return bj * FF + 128 * pn + i; }
    if (r >= 4608) return 4616 + (r - 4608);
    const int t = r >> 9, i = r & 511;
    const int base = (t == 0) ? 0 : (t == 1) ? 512 : (t == 2) ? 1024 : (t == 3) ? 2056 : (t == 4) ? 3592 : (t == 5) ? 4104 : (t == 6) ? 1536 : (t == 7) ? 2568 : 3080;
    return base + i;
}
__device__ __forceinline__ void conv_matrix(const float* W, int ldw, int K, int Ndst, bf16* WT, int mode, LAS float* scr) {
    const int lane = ltid() & 63; const int nblk = Ndst / 32, nitems = (K / 64) * nblk;
    for (int it = GWAVE; it < nitems; it += NGWAVE) {
        const int kb = it / nblk, nb = it % nblk, k0 = 64 * kb, r0 = 32 * nb, c0 = srccol(mode, r0);
#pragma unroll 8
        for (int i = 0; i < 32; ++i) { const int kk = 2 * i + (lane >> 5); scr[kk * 33 + (lane & 31)] = W[(size_t)(k0 + kk) * ldw + c0 + (lane & 31)]; }
        asm volatile("s_waitcnt lgkmcnt(0)" ::: "memory");
        const int c = lane & 7;
#pragma unroll
        for (int j = 0; j < 4; ++j) { const int n = (lane >> 3) + 8 * j; const LAS float* s = scr + (8 * c) * 33 + n;
            u32x4 o; o.x = pk2(s[0 * 33], s[1 * 33]); o.y = pk2(s[2 * 33], s[3 * 33]); o.z = pk2(s[4 * 33], s[5 * 33]); o.w = pk2(s[6 * 33], s[7 * 33]);
            *(u32x4*)(WT + (size_t)(r0 + n) * K + k0 + 8 * c) = o; }
        asm volatile("s_waitcnt lgkmcnt(0)" ::: "memory");
    }
}
__device__ __forceinline__ void phase_convert(const Params& p, int l, LAS unsigned char* lds) {
    LAS float* scr = (LAS float*)(lds + (ltid() >> 6) * 16384);
    unsigned char* ws = p.ws;
    for (int f = 0; f < 2; ++f) {
        conv_matrix(p.ffn_w12 + ((size_t)l * 2 + f) * D * 2 * FF, 2 * FF, D, 2 * FF, (bf16*)(ws + WS_W12T) + (size_t)f * 2 * FF * D, 1, scr);
        conv_matrix(p.ffn_w3 + ((size_t)l * 2 + f) * FF * D, D, FF, D, (bf16*)(ws + WS_W3T) + (size_t)f * D * FF, 0, scr);
    }
    conv_matrix(p.mix_w_in + (size_t)l * D * NIN, NIN, D, 7680, (bf16*)(ws + WS_WINT), 2, scr);
    for (int r = 0; r < 3; ++r) conv_matrix(p.w_branch + ((size_t)l * 3 + r) * 512 * D, D, 512, D, (bf16*)(ws + WS_WBRT) + (size_t)r * D * 512, 0, scr);
    conv_matrix(p.mix_w_out + (size_t)l * D * D, D, D, D, (bf16*)(ws + WS_WOUTT), 0, scr);
    conv_matrix(p.xa_wq + (size_t)l * D * D, D, D, D, (bf16*)(ws + WS_WQT), 0, scr);
    conv_matrix(p.xa_wo + (size_t)l * D * D, D, D, D, (bf16*)(ws + WS_WOT), 0, scr);
    conv_matrix(p.xa_wkv + (size_t)l * D * 2 * D, 2 * D, D, 2 * D, (bf16*)(ws + WS_WKVT), 0, scr);
}
__device__ __forceinline__ void cvt_rows(const float* src, bf16* dst, size_t n) {
    for (size_t i = (size_t)GTID * 4; i < n; i += (size_t)GSZ * 4) { const f32x4 v = *(const f32x4*)(src + i); uint2 o; o.x = pk2(v.x, v.y); o.y = pk2(v.z, v.w); *(uint2*)(dst + i) = o; }
}

__device__ __forceinline__ float dot_bf16(const bf16* a, const bf16* b, int K) {
    float acc = 0.f;
    for (int k = 0; k < K; k += 8) {
        const u32x4 av = *(const u32x4*)(a + k), bv = *(const u32x4*)(b + k);
        acc += bflo(av.x) * bflo(bv.x) + bfhi(av.x) * bfhi(bv.x) + bflo(av.y) * bflo(bv.y) + bfhi(av.y) * bfhi(bv.y)
             + bflo(av.z) * bflo(bv.z) + bfhi(av.z) * bfhi(bv.z) + bflo(av.w) * bflo(bv.w) + bfhi(av.w) * bfhi(bv.w);
    }
    return acc;
}
template <class F> __device__ __forceinline__ void naive_gemm(const bf16* A, int lda, const bf16* Bt, int K, int Mr, int Nc, F f) {
    const size_t tot = (size_t)Mr * Nc;
    for (size_t idx = GTID; idx < tot; idx += GSZ) { const int r = (int)(idx / Nc), c = (int)(idx % Nc); f(r, c, dot_bf16(A + (size_t)r * lda, Bt + (size_t)c * K, K)); }
}

__device__ __forceinline__ void phase_ln(float* X, bf16* XB, const float* g, const float* b, float* BA, const float* w_in) {
    const int lane = ltid() & 63;
    for (int m = GWAVE; m < M; m += NGWAVE) {
        f32x4* xr = (f32x4*)(X + (size_t)m * D) + lane;
        f32x4 v[4]; float s = 0.f;
#pragma unroll
        for (int j = 0; j < 4; ++j) { v[j] = xr[64 * j]; s += (v[j].x + v[j].y) + (v[j].z + v[j].w); }
        const float mean = wave_sum(s) * (1.f / D); float s2 = 0.f;
#pragma unroll
        for (int j = 0; j < 4; ++j) { v[j] = v[j] - mean; s2 += (v[j].x * v[j].x + v[j].y * v[j].y) + (v[j].z * v[j].z + v[j].w * v[j].w); }
        const float rstd = rsqrtf(wave_sum(s2) * (1.f / D) + LN_EPS);
#pragma unroll
        for (int j = 0; j < 4; ++j) {
            const f32x4 gg = *((const f32x4*)g + lane + 64 * j), bb = *((const f32x4*)b + lane + 64 * j);
            v[j] = v[j] * rstd * gg + bb; xr[64 * j] = v[j];
            uint2 o; o.x = pk2(v[j].x, v[j].y); o.y = pk2(v[j].z, v[j].w); *((uint2*)(XB + (size_t)m * D) + lane + 64 * j) = o;
        }
        if (BA) {
            float acc[8];
#pragma unroll
            for (int c = 0; c < 8; ++c) acc[c] = 0.f;
#pragma unroll 1
            for (int j = 0; j < 4; ++j)
#pragma unroll 1
                for (int e = 0; e < 4; ++e) {
                    const int k = 4 * lane + 256 * j + e; const float xv = v[j][e];
                    const f32x4 w0 = *(const f32x4*)(w_in + (size_t)k * NIN + 2048), w1 = *(const f32x4*)(w_in + (size_t)k * NIN + 2052);
                    acc[0] += xv * w0.x; acc[1] += xv * w0.y; acc[2] += xv * w0.z; acc[3] += xv * w0.w;
                    acc[4] += xv * w1.x; acc[5] += xv * w1.y; acc[6] += xv * w1.z; acc[7] += xv * w1.w;
                }
#pragma unroll
            for (int c = 0; c < 8; ++c) acc[c] = wave_sum(acc[c]);
            if (lane == 0) { *(f32x4*)(BA + (size_t)m * 8) = (f32x4){acc[0], acc[1], acc[2], acc[3]}; *(f32x4*)(BA + (size_t)m * 8 + 4) = (f32x4){acc[4], acc[5], acc[6], acc[7]}; }
        }
    }
}

__device__ __forceinline__ void phase_dn_naive(const Params& p, int l, LAS unsigned char* lds) {
    unsigned char* ws = p.ws;
    const bf16* DQ = (const bf16*)(ws + WS_PROJ); const bf16* DK = DQ + (size_t)M * 512; const bf16* DV = DK + (size_t)M * 512;
    const float* BA = (const float*)(ws + WS_BA); bf16* ORAW = (bf16*)(ws + WS_ORAW);
    LAS float* qs = (LAS float*)lds; LAS float* ks = qs + 128; LAS float* vs = ks + 128; LAS float* red = vs + 128;
    LAS float* part = red + 8;
    const int tid = ltid(), lane = tid & 63, wv = tid >> 6;
    for (int item = blockIdx.x; item < 8; item += gridDim.x) {
        const int b = item >> 2, h = item & 3; const int d = tid & 127, kq = tid >> 7; const bool act = tid < 128;
        float S[32];
#pragma unroll
        for (int k = 0; k < 32; ++k) S[k] = 0.f;
        const float* cw = p.dn_conv_w + (size_t)l * 4 * 1536;
        float wq[4], wk[4], wvv[4];
#pragma unroll
        for (int j = 0; j < 4; ++j) { wq[j] = cw[j * 1536 + h * 128 + d]; wk[j] = cw[j * 1536 + 512 + h * 128 + d]; wvv[j] = cw[j * 1536 + 1024 + h * 128 + d]; }
        const float Aexp = expf(p.dn_a_log[l * 4 + h]), dtb = p.dn_dt_bias[l * 4 + h];
        float hq0 = 0, hq1 = 0, hq2 = 0, hk0 = 0, hk1 = 0, hk2 = 0, hv0 = 0, hv1 = 0, hv2 = 0;
        for (int t = 0; t < SEQ; ++t) {
            const size_t row = (size_t)b * SEQ + t;
            float qv = 0.f, kv = 0.f, vv = 0.f;
            if (act) {
                const float xq = bf2f(DQ[row * 512 + h * 128 + d]), xk = bf2f(DK[row * 512 + h * 128 + d]), xv = bf2f(DV[row * 512 + h * 128 + d]);
                qv = siluf_(wq[0] * hq0 + wq[1] * hq1 + wq[2] * hq2 + wq[3] * xq); hq0 = hq1; hq1 = hq2; hq2 = xq;
                kv = siluf_(wk[0] * hk0 + wk[1] * hk1 + wk[2] * hk2 + wk[3] * xk); hk0 = hk1; hk1 = hk2; hk2 = xk;
                vv = siluf_(wvv[0] * hv0 + wvv[1] * hv1 + wvv[2] * hv2 + wvv[3] * xv); hv0 = hv1; hv1 = hv2; hv2 = xv;
            }
            const float sq = wave_sum(qv * qv), sk = wave_sum(kv * kv);
            if (act && lane == 0) { red[wv * 2] = sq; red[wv * 2 + 1] = sk; }
            __syncthreads();
            const float nq = rsqrtf(red[0] + red[2] + NORM_EPS) * 0.08838834764831845f, nk = rsqrtf(red[1] + red[3] + NORM_EPS);
            if (act) { qs[d] = qv * nq; ks[d] = kv * nk; vs[d] = vv; }
            __syncthreads();
            const float beta = sigmoidf_(BA[row * 8 + h]);
            const float g = -Aexp * softplusf_(BA[row * 8 + 4 + h] + dtb); const float eg = expf(g);
            float kS = 0.f;
#pragma unroll
            for (int k = 0; k < 32; ++k) kS += ks[kq * 32 + k] * S[k];
            part[kq * 128 + d] = kS;
            __syncthreads();
            kS = (part[d] + part[128 + d]) + (part[256 + d] + part[384 + d]);
            const float coef = beta * (vs[d] - eg * kS);
            float o = 0.f;
#pragma unroll
            for (int k = 0; k < 32; ++k) { S[k] = eg * S[k] + ks[kq * 32 + k] * coef; o += qs[kq * 32 + k] * S[k]; }
            __syncthreads();
            part[kq * 128 + d] = o;
            __syncthreads();
            if (act) { o = (part[d] + part[128 + d]) + (part[256 + d] + part[384 + d]); ORAW[row * 512 + h * 128 + d] = (bf16)f2bf(o); }
        }
        __syncthreads();
    }
}
typedef short bf16x8 __attribute__((ext_vector_type(8)));
__device__ __forceinline__ f32x4 mfma16(bf16x8 a, bf16x8 b, f32x4 c) { return __builtin_amdgcn_mfma_f32_16x16x32_bf16(a, b, c, 0, 0, 0); }
__device__ __forceinline__ bf16x8 ldfrag(const LAS unsigned char* base, int row, int stride_bytes, int k0) { return *(const LAS bf16x8*)(base + row * stride_bytes + k0 * 2); }

constexpr size_t WS_DU = WS_R2, WS_DW = WS_R2 + 16 * MiB, WS_DQD = WS_R2 + 32 * MiB, WS_DKDT = WS_R2 + 48 * MiB, WS_DQK = WS_R2 + 64 * MiB;
__device__ __forceinline__ void phase_dn_prep(const Params& p, int l, LAS unsigned char* lds) {
    unsigned char* ws = p.ws;
    const bf16* DQ = (const bf16*)(ws + WS_PROJ); const bf16* DK = DQ + (size_t)M * 512; const bf16* DV = DK + (size_t)M * 512;
    const float* BA = (const float*)(ws + WS_BA);
    bf16* U = (bf16*)(ws + WS_DU); bf16* Wm = (bf16*)(ws + WS_DW); bf16* QD = (bf16*)(ws + WS_DQD); bf16* KDT = (bf16*)(ws + WS_DKDT); bf16* QK = (bf16*)(ws + WS_DQK);
    float* GLAST = (float*)(ws + WS_GLAST);
    LAS float* kf = (LAS float*)lds;
    LAS float* vf = kf + 64 * 132;
    LAS unsigned char* qb = (LAS unsigned char*)(vf + 64 * 132);
    LAS unsigned char* kb = qb + 64 * 272;
    LAS float* mm = (LAS float*)(kb + 64 * 272);
    LAS float* gs = mm + 64 * 68;
    LAS float* bs = gs + 64;
    LAS float* eG = bs + 64;
    LAS float* ones = eG + 64;
    const int tid = ltid(), lane = tid & 63, wv = tid >> 6, fr = lane & 15, fq = lane >> 4;
    const float* cw = p.dn_conv_w + (size_t)l * 4 * 1536;
    for (int item = blockIdx.x; item < BATCH * NCHUNK * 4; item += gridDim.x) {
        const int h = item & 3, c = (item >> 2) & (NCHUNK - 1), b = item >> 9;
        const size_t row0 = (size_t)b * SEQ + (size_t)c * 64;
        const float Aexp = expf(p.dn_a_log[l * 4 + h]), dtb = p.dn_dt_bias[l * 4 + h];
        {
            const int d = 2 * lane, ch = h * 128 + d;
            float wq[4][2], wk[4][2], wvv[4][2];
#pragma unroll
            for (int j = 0; j < 4; ++j) { wq[j][0] = cw[j * 1536 + ch]; wq[j][1] = cw[j * 1536 + ch + 1]; wk[j][0] = cw[j * 1536 + 512 + ch]; wk[j][1] = cw[j * 1536 + 512 + ch + 1];
                wvv[j][0] = cw[j * 1536 + 1024 + ch]; wvv[j][1] = cw[j * 1536 + 1024 + ch + 1]; }
#pragma unroll 2
            for (int rr = 0; rr < 8; ++rr) {
                const int r = wv * 8 + rr; const int tpos = c * 64 + r;
                float q0 = 0.f, q1 = 0.f, k0 = 0.f, k1 = 0.f, v0 = 0.f, v1 = 0.f;
#pragma unroll
                for (int j = 0; j < 4; ++j) {
                    if (tpos - 3 + j >= 0) {
                        const size_t o = (row0 + r - 3 + j) * 512 + ch;
                        const unsigned xq = *(const unsigned*)(DQ + o), xk = *(const unsigned*)(DK + o), xv = *(const unsigned*)(DV + o);
                        q0 += wq[j][0] * bflo(xq); q1 += wq[j][1] * bfhi(xq); k0 += wk[j][0] * bflo(xk); k1 += wk[j][1] * bfhi(xk); v0 += wvv[j][0] * bflo(xv); v1 += wvv[j][1] * bfhi(xv);
                    }
                }
                q0 = siluf_(q0); q1 = siluf_(q1); k0 = siluf_(k0); k1 = siluf_(k1); v0 = siluf_(v0); v1 = siluf_(v1);
                const float nq = rsqrtf(wave_sum(q0 * q0 + q1 * q1) + NORM_EPS) * 0.08838834764831845f, nk = rsqrtf(wave_sum(k0 * k0 + k1 * k1) + NORM_EPS);
                q0 *= nq; q1 *= nq; k0 *= nk; k1 *= nk;
                *(LAS unsigned*)(qb + r * 272 + d * 2) = pk2(q0, q1); *(LAS unsigned*)(kb + r * 272 + d * 2) = pk2(k0, k1);
                kf[r * 132 + d] = k0; kf[r * 132 + d + 1] = k1; vf[r * 132 + d] = v0; vf[r * 132 + d + 1] = v1;
                if (lane == 0) { bs[r] = sigmoidf_(BA[(row0 + r) * 8 + h]); gs[r] = -Aexp * softplusf_(BA[(row0 + r) * 8 + 4 + h] + dtb); }
            }
        }
        __syncthreads();
        if (wv == 0) {
            float v = gs[lane];
#pragma unroll
            for (int o = 1; o < 64; o <<= 1) { const float t = __shfl_up(v, o); if (lane >= o) v += t; }
            gs[lane] = v; eG[lane] = expf(v); ones[lane] = 1.f;
        }
        __syncthreads();
#pragma unroll
        for (int tt = 0; tt < 2; ++tt) {
            const int T = 2 * wv + tt, ti = T >> 2, tj = T & 3;
            f32x4 aK = {0.f, 0.f, 0.f, 0.f}, aQ = {0.f, 0.f, 0.f, 0.f};
#pragma unroll
            for (int ks = 0; ks < 4; ++ks) {
                const bf16x8 bj_ = ldfrag(kb, tj * 16 + fr, 272, ks * 32 + fq * 8);
                aK = mfma16(ldfrag(kb, ti * 16 + fr, 272, ks * 32 + fq * 8), bj_, aK);
                aQ = mfma16(ldfrag(qb, ti * 16 + fr, 272, ks * 32 + fq * 8), bj_, aQ);
            }
            const int j = tj * 16 + fr; const float Gj = gs[j];
#pragma unroll
            for (int jj = 0; jj < 4; ++jj) {
                const int i = ti * 16 + fq * 4 + jj;
                const float dec = (i >= j) ? __expf(gs[i] - Gj) : 0.f;
                mm[i * 68 + j] = (i > j) ? bs[i] * aK[jj] * dec : 0.f;
                QK[((size_t)item * 64 + i) * 64 + j] = (bf16)f2bf(aQ[jj] * dec);
            }
        }
        __syncthreads();
        if (tid < 256) {
            const int col = tid & 127; const bool isw = tid >= 128;
            float sol[64];
            const LAS float* srcp = (isw ? kf : vf) + col; const LAS float* mmv = mm; const LAS float* bsv = bs; const LAS float* epv = isw ? eG : ones;
            asm volatile("" : "+v"(srcp), "+v"(mmv), "+v"(bsv), "+v"(epv));
#pragma unroll
            for (int i = 0; i < 64; ++i) {
                float acc = srcp[i * 132] * bsv[i] * epv[i];
#pragma unroll
                for (int j4 = 0; j4 < i; j4 += 4) {
                    const f32x4 mv = *(const LAS f32x4*)(mmv + i * 68 + j4);
                    acc -= mv.x * sol[j4];
                    if (j4 + 1 < i) acc -= mv.y * sol[j4 + 1];
                    if (j4 + 2 < i) acc -= mv.z * sol[j4 + 2];
                    if (j4 + 3 < i) acc -= mv.w * sol[j4 + 3];
                }
                sol[i] = acc;
                __builtin_amdgcn_sched_barrier(0);
            }
            bf16* dst = (isw ? Wm : U) + row0 * 512 + h * 128 + col;
#pragma unroll
            for (int i = 0; i < 64; ++i) dst[(size_t)i * 512] = (bf16)f2bf(sol[i]);
        } else {
            const int t2 = tid - 256;
            { const int d2 = t2 & 63;
#pragma unroll 4
              for (int k = 0; k < 16; ++k) { const int i = (t2 >> 6) + 4 * k; const unsigned qv = *(const LAS unsigned*)(qb + i * 272 + d2 * 4); const float e = eG[i];
                  *(unsigned*)(QD + (row0 + i) * 512 + h * 128 + 2 * d2) = pk2(bflo(qv) * e, bfhi(qv) * e); } }
            { const int j2 = t2 & 31; const float Gl = gs[63]; const float e0 = __expf(Gl - gs[2 * j2]), e1 = __expf(Gl - gs[2 * j2 + 1]);
#pragma unroll 4
              for (int k = 0; k < 16; ++k) { const int d = (t2 >> 5) + 8 * k;
                  *(unsigned*)(KDT + ((size_t)item * 128 + d) * 64 + 2 * j2) = pk2(kf[(2 * j2) * 132 + d] * e0, kf[(2 * j2 + 1) * 132 + d] * e1); } }
            if (t2 == 0) GLAST[item] = eG[63];
        }
        __syncthreads();
    }
}

__device__ __forceinline__ void phase_dn_scan(const Params& p, LAS unsigned char* lds, bf16* ORAW) {
    unsigned char* ws = p.ws;
    const bf16* U = (const bf16*)(ws + WS_DU); const bf16* Wm = (const bf16*)(ws + WS_DW); const bf16* QD = (const bf16*)(ws + WS_DQD); const bf16* KDT = (const bf16*)(ws + WS_DKDT); const bf16* QK = (const bf16*)(ws + WS_DQK);
    const float* GLAST = (const float*)(ws + WS_GLAST);
    constexpr int TB = 64512;
    LAS unsigned char* St = lds + 2 * TB;
    LAS unsigned char* VNt = St + 16 * 272;
    const int tid = ltid(), lane = tid & 63, wv = tid >> 6, fr = lane & 15, fq = lane >> 4;
    for (int item = blockIdx.x; item < 64; item += gridDim.x) {
        const int vg = item & 7, h = (item >> 3) & 3, b = item >> 5;
        u32x4 pw[2], pq[2], pk[2], pqk, pu; float gl_next = 0.f;
        pu = (u32x4){0u, 0u, 0u, 0u};
#define DN_LOAD(cc) do { const size_t r0_ = (size_t)b * SEQ + (size_t)(cc) * 64; const size_t ich_ = ((size_t)b * NCHUNK + (cc)) * 4 + h; \
            _Pragma("unroll") for (int k_ = 0; k_ < 2; ++k_) { const int pp_ = tid + 512 * k_; \
                pw[k_] = *(const u32x4*)(Wm + (r0_ + (pp_ >> 4)) * 512 + h * 128 + (pp_ & 15) * 8); pq[k_] = *(const u32x4*)(QD + (r0_ + (pp_ >> 4)) * 512 + h * 128 + (pp_ & 15) * 8); \
                pk[k_] = *(const u32x4*)(KDT + (ich_ * 128 + (pp_ >> 3)) * 64 + (pp_ & 7) * 8); } \
            pqk = *(const u32x4*)(QK + (ich_ * 64 + (tid >> 3)) * 64 + (tid & 7) * 8); \
            if (tid < 128) pu = *(const u32x4*)(U + (r0_ + (tid >> 1)) * 512 + h * 128 + vg * 16 + (tid & 1) * 8); \
            gl_next = GLAST[ich_]; } while (0)
#define DN_STORE(buf) do { LAS unsigned char* tb_ = lds + (buf) * TB; \
            _Pragma("unroll") for (int k_ = 0; k_ < 2; ++k_) { const int pp_ = tid + 512 * k_; \
                *(LAS u32x4*)(tb_ + (pp_ >> 4) * 272 + (pp_ & 15) * 16) = pw[k_]; *(LAS u32x4*)(tb_ + 17408 + (pp_ >> 4) * 272 + (pp_ & 15) * 16) = pq[k_]; \
                *(LAS u32x4*)(tb_ + 34816 + (pp_ >> 3) * 144 + (pp_ & 7) * 16) = pk[k_]; } \
            *(LAS u32x4*)(tb_ + 53248 + (tid >> 3) * 144 + (tid & 7) * 16) = pqk; \
            if (tid < 128) *(LAS u32x4*)(tb_ + 62464 + (tid >> 1) * 32 + (tid & 1) * 16) = pu; } while (0)
        DN_LOAD(0);
        for (int i = tid; i < 16 * 272 / 4; i += NT) ((LAS unsigned*)St)[i] = 0u;
        DN_STORE(0);
        float gl = gl_next;
        f32x4 Sacc[2] = {{0.f, 0.f, 0.f, 0.f}, {0.f, 0.f, 0.f, 0.f}};
        __syncthreads();
        for (int c = 0; c < NCHUNK; ++c) {
            const int buf = c & 1; const LAS unsigned char* tb = lds + buf * TB;
            if (c + 1 < NCHUNK) DN_LOAD(c + 1);
            const int rt = wv & 3;
            f32x4 acc = {0.f, 0.f, 0.f, 0.f};
            {
                const LAS unsigned char* Ab = tb + (wv < 4 ? 0 : 17408);
#pragma unroll
                for (int ks = 0; ks < 4; ++ks) acc = mfma16(ldfrag(Ab, rt * 16 + fr, 272, ks * 32 + fq * 8), ldfrag(St, fr, 272, ks * 32 + fq * 8), acc);
            }
            if (wv < 4) {
                float vn[4];
#pragma unroll
                for (int jj = 0; jj < 4; ++jj) vn[jj] = bf2f(*(const LAS unsigned short*)(tb + 62464 + (rt * 16 + fq * 4 + jj) * 32 + fr * 2)) - acc[jj];
                u32x2 w; w.x = pk2(vn[0], vn[1]); w.y = pk2(vn[2], vn[3]);
                *(LAS u32x2*)(VNt + fr * 144 + (rt * 16 + fq * 4) * 2) = w;
            }
            __syncthreads();
            if (wv >= 4) {
#pragma unroll
                for (int ks = 0; ks < 2; ++ks) acc = mfma16(ldfrag(tb + 53248, rt * 16 + fr, 144, ks * 32 + fq * 8), ldfrag(VNt, fr, 144, ks * 32 + fq * 8), acc);
                const size_t r0 = (size_t)b * SEQ + (size_t)c * 64;
#pragma unroll
                for (int jj = 0; jj < 4; ++jj) ORAW[(r0 + rt * 16 + fq * 4 + jj) * 512 + h * 128 + vg * 16 + fr] = (bf16)f2bf(acc[jj]);
            } else {
#pragma unroll
                for (int t2 = 0; t2 < 2; ++t2) {
                    const int dt = 2 * wv + t2; f32x4 s = Sacc[t2] * gl;
#pragma unroll
                    for (int ks = 0; ks < 2; ++ks) s = mfma16(ldfrag(tb + 34816, dt * 16 + fr, 144, ks * 32 + fq * 8), ldfrag(VNt, fr, 144, ks * 32 + fq * 8), s);
                    Sacc[t2] = s;
                    u32x2 w; w.x = pk2(s[0], s[1]); w.y = pk2(s[2], s[3]);
                    *(LAS u32x2*)(St + fr * 272 + (dt * 16 + fq * 4) * 2) = w;
                }
            }
            if (c + 1 < NCHUNK) { DN_STORE(buf ^ 1); gl = gl_next; }
            __syncthreads();
        }
#undef DN_LOAD
#undef DN_STORE
    }
}

__device__ __forceinline__ void phase_dn_post(const Params& p, int l, const bf16* ORAW) {
    unsigned char* ws = p.ws; bf16* DZ = (bf16*)(ws + WS_PROJ) + (size_t)6 * M * 512;
    const int lane = ltid() & 63; const float* nw = p.dn_norm_w + (size_t)l * 128;
    for (int m = GWAVE; m < M; m += NGWAVE) {
        const u32x4 ov = *((const u32x4*)(ORAW + (size_t)m * 512) + lane), zv = *((const u32x4*)(DZ + (size_t)m * 512) + lane);
        float o[8] = {bflo(ov.x), bfhi(ov.x), bflo(ov.y), bfhi(ov.y), bflo(ov.z), bfhi(ov.z), bflo(ov.w), bfhi(ov.w)};
        float z[8] = {bflo(zv.x), bfhi(zv.x), bflo(zv.y), bfhi(zv.y), bflo(zv.z), bfhi(zv.z), bflo(zv.w), bfhi(zv.w)};
        float s = 0.f;
#pragma unroll
        for (int e = 0; e < 8; ++e) s += o[e] * o[e];
        s += __shfl_xor(s, 1); s += __shfl_xor(s, 2); s += __shfl_xor(s, 4); s += __shfl_xor(s, 8);
        const float r = rsqrtf(s * (1.f / 128.f) + NORM_EPS);
        const int d0 = (lane & 15) * 8; float y[8];
#pragma unroll
        for (int e = 0; e < 8; ++e) y[e] = o[e] * r * nw[d0 + e] * siluf_(z[e]);
        u32x4 w; w.x = pk2(y[0], y[1]); w.y = pk2(y[2], y[3]); w.z = pk2(y[4], y[5]); w.w = pk2(y[6], y[7]);
        *((u32x4*)(DZ + (size_t)m * 512) + lane) = w;
    }
}

__device__ __forceinline__ void phase_lru_a1(const Params& p, int l) {
    unsigned char* ws = p.ws; const bf16* LX = (const bf16*)(ws + WS_PROJ) + (size_t)3 * M * 512; float* XC = (float*)(ws + WS_XC);
    const float* cw = p.lru_conv_w + (size_t)l * 4 * 512; const float* cb = p.lru_conv_b + (size_t)l * 512;
    for (size_t idx = GTID; idx < (size_t)M * 512; idx += GSZ) {
        const int row = (int)(idx >> 9), ch = (int)(idx & 511), t = row & (SEQ - 1);
        float acc = cb[ch];
#pragma unroll
        for (int j = 0; j < 4; ++j) { const int tt = t - 3 + j; if (tt >= 0) acc += cw[j * 512 + ch] * bf2f(LX[(size_t)(row - 3 + j) * 512 + ch]); }
        XC[idx] = acc;
    }
}
__device__ __forceinline__ void phase_lru_a2(const Params& p, int l, float* LA, float* LU) {
    unsigned char* ws = p.ws; const float* XC = (const float*)(ws + WS_XC);
    const float* gw = p.lru_gate_w + (size_t)l * 2 * 8 * 64 * 64; const float* gb = p.lru_gate_b + (size_t)l * 2 * 512; const float* lam = p.lru_lambda + (size_t)l * 512;
    for (size_t idx = GTID; idx < (size_t)M * 512; idx += GSZ) {
        const int row = (int)(idx >> 9), ch = (int)(idx & 511), n = ch >> 6, e = ch & 63;
        const float* xr = XC + (size_t)row * 512 + n * 64;
        float g0 = gb[ch], g1 = gb[512 + ch];
        for (int dd = 0; dd < 64; ++dd) { const float xv = xr[dd]; g0 += xv * gw[((size_t)(0 * 8 + n) * 64 + dd) * 64 + e]; g1 += xv * gw[((size_t)(1 * 8 + n) * 64 + dd) * 64 + e]; }
        const float r = sigmoidf_(g0), ig = sigmoidf_(g1);
        const float log_a = -8.f * r * softplusf_(-lam[ch]);
        const float a = expf(log_a);
        LA[idx] = a; LU[idx] = XC[idx] * ig * sqrtf(-expm1f(2.f * log_a));
    }
}
__device__ __forceinline__ void phase_lru_b(const Params& p, const float* LA, const float* LU) {
    unsigned char* ws = p.ws; bf16* LG = (bf16*)(ws + WS_PROJ) + (size_t)7 * M * 512;
    for (int idx = GTID; idx < BATCH * 512; idx += GSZ) {
        const int b = idx >> 9, ch = idx & 511; float h = 0.f;
        for (int t = 0; t < SEQ; ++t) { const size_t o = ((size_t)b * SEQ + t) * 512 + ch; h = LA[o] * h + LU[o]; LG[o] = (bf16)f2bf(h * gelu_tanh(bf2f(LG[o]))); }
    }
}

__device__ __forceinline__ void phase_band_naive(const Params& p, int l) {
    unsigned char* ws = p.ws; bf16* AQ = (bf16*)(ws + WS_PROJ) + (size_t)8 * M * 512; const bf16* AK = (const bf16*)(ws + WS_PROJ) + (size_t)4 * M * 512; const bf16* AV = AK + (size_t)M * 512;
    const float* tab = p.la_rel_bias + (size_t)l * 8 * 257;
    for (int idx = GTID; idx < M * 16; idx += GSZ) {
        const int row = idx >> 4, h = (idx >> 1) & 7, hd = idx & 1, b = row >> 13, t = row & (SEQ - 1), c = t >> 6;
        float o[32];
        const bf16* qp = AQ + (size_t)row * 512 + h * 64;
#pragma unroll
        for (int e = 0; e < 32; ++e) o[e] = 0.f;
        float mx = -3e38f, ls = 0.f;
        const int c0 = c - 8 < 0 ? 0 : c - 8;
        for (int kt = c0 * 64; kt < (c + 1) * 64; ++kt) {
            const size_t kr = (size_t)b * SEQ + kt;
            float s = 0.f;
#pragma unroll 2
            for (int e = 0; e < 8; ++e) { const u32x4 v = *((const u32x4*)(AK + kr * 512 + h * 64) + e); const u32x4 qq = *((const u32x4*)qp + e);
                s += bflo(qq.x) * bflo(v.x) + bfhi(qq.x) * bfhi(v.x) + bflo(qq.y) * bflo(v.y) + bfhi(qq.y) * bfhi(v.y) + bflo(qq.z) * bflo(v.z) + bfhi(qq.z) * bfhi(v.z) + bflo(qq.w) * bflo(v.w) + bfhi(qq.w) * bfhi(v.w); }
            int rel = kt - t; rel = rel < -128 ? -128 : (rel > 128 ? 128 : rel);
            s = s * 0.125f + tab[h * 257 + rel + 128];
            const float mn = fmaxf(mx, s), sc = __expf(mx - mn), pe = __expf(s - mn);
            ls = ls * sc + pe; mx = mn;
#pragma unroll
            for (int e = 0; e < 4; ++e) { const u32x4 v = *((const u32x4*)(AV + kr * 512 + h * 64 + hd * 32) + e);
                o[8 * e] = o[8 * e] * sc + pe * bflo(v.x); o[8 * e + 1] = o[8 * e + 1] * sc + pe * bfhi(v.x); o[8 * e + 2] = o[8 * e + 2] * sc + pe * bflo(v.y); o[8 * e + 3] = o[8 * e + 3] * sc + pe * bfhi(v.y);
                o[8 * e + 4] = o[8 * e + 4] * sc + pe * bflo(v.z); o[8 * e + 5] = o[8 * e + 5] * sc + pe * bfhi(v.z); o[8 * e + 6] = o[8 * e + 6] * sc + pe * bflo(v.w); o[8 * e + 7] = o[8 * e + 7] * sc + pe * bfhi(v.w); }
        }
        const float inv = 1.f / ls;
#pragma unroll
        for (int e = 0; e < 4; ++e) { u32x4 w; w.x = pk2(o[8 * e] * inv, o[8 * e + 1] * inv); w.y = pk2(o[8 * e + 2] * inv, o[8 * e + 3] * inv); w.z = pk2(o[8 * e + 4] * inv, o[8 * e + 5] * inv); w.w = pk2(o[8 * e + 6] * inv, o[8 * e + 7] * inv);
            *((u32x4*)(AQ + (size_t)row * 512 + h * 64 + hd * 32) + e) = w; }
    }
}

constexpr size_t WS_HL = WS_R2 + 72 * MiB, WS_CA = WS_R2 + 88 * MiB;
__device__ __forceinline__ void phase_lru_b1(const Params& p, int l, LAS unsigned char* lds, int blk0, int nblk) {
    unsigned char* ws = p.ws; const bf16* LX = (const bf16*)(ws + WS_PROJ) + (size_t)3 * M * 512;
    bf16* HL = (bf16*)(ws + WS_HL); bf16* CA = (bf16*)(ws + WS_CA); float* PE = (float*)(ws + WS_LRUPE);
    LAS float* xcs = (LAS float*)lds;
    const int ch = ltid(), n = ch >> 6, e = ch & 63;
    const float* cw = p.lru_conv_w + (size_t)l * 4 * 512; const float* gw = p.lru_gate_w + (size_t)l * 2 * 8 * 64 * 64;
    const float w0 = cw[ch], w1 = cw[512 + ch], w2 = cw[1024 + ch], w3 = cw[1536 + ch], cb = p.lru_conv_b[(size_t)l * 512 + ch];
    const float gb0 = p.lru_gate_b[(size_t)l * 1024 + ch], gb1 = p.lru_gate_b[(size_t)l * 1024 + 512 + ch];
    const float sp8 = 8.f * softplusf_(-p.lru_lambda[(size_t)l * 512 + ch]);
    for (int item = (int)blockIdx.x - blk0; item < BATCH * NCHUNK; item += nblk) {
        const int b = item >> 7, c = item & (NCHUNK - 1); const size_t row0 = (size_t)b * SEQ + (size_t)c * 64;
        float x0 = 0.f, x1 = 0.f, x2 = 0.f;
        if (c > 0) { x0 = bf2f(LX[(row0 - 3) * 512 + ch]); x1 = bf2f(LX[(row0 - 2) * 512 + ch]); x2 = bf2f(LX[(row0 - 1) * 512 + ch]); }
        float hh = 0.f, ca = 1.f;
#pragma unroll 1
        for (int sb = 0; sb < 2; ++sb) {
            __syncthreads();
#pragma unroll 4
            for (int tt = 0; tt < 32; ++tt) { const float x3 = bf2f(LX[(row0 + sb * 32 + tt) * 512 + ch]); xcs[ch * 36 + tt] = cb + w0 * x0 + w1 * x1 + w2 * x2 + w3 * x3; x0 = x1; x1 = x2; x2 = x3; }
            __syncthreads();
            float a0[32], a1[32];
#pragma unroll
            for (int tt = 0; tt < 32; ++tt) { a0[tt] = gb0; a1[tt] = gb1; }
            const LAS float* xb = xcs + (n * 64) * 36;
#pragma unroll 2
            for (int dd = 0; dd < 64; ++dd) {
                const float g0 = gw[((size_t)(0 * 8 + n) * 64 + dd) * 64 + e], g1 = gw[((size_t)(1 * 8 + n) * 64 + dd) * 64 + e];
#pragma unroll
                for (int t4 = 0; t4 < 8; ++t4) { const f32x4 xv = *(const LAS f32x4*)(xb + dd * 36 + 4 * t4);
                    a0[4 * t4] += xv.x * g0; a0[4 * t4 + 1] += xv.y * g0; a0[4 * t4 + 2] += xv.z * g0; a0[4 * t4 + 3] += xv.w * g0;
                    a1[4 * t4] += xv.x * g1; a1[4 * t4 + 1] += xv.y * g1; a1[4 * t4 + 2] += xv.z * g1; a1[4 * t4 + 3] += xv.w * g1; }
            }
#pragma unroll
            for (int tt = 0; tt < 32; ++tt) {
                const float r = sigmoidf_(a0[tt]), ig = sigmoidf_(a1[tt]);
                const float log_a = -sp8 * r, a = __expf(log_a);
                const float u = xcs[ch * 36 + tt] * ig * sqrtf(-expm1f(2.f * log_a));
                hh = a * hh + u; ca *= a;
                const size_t o = (row0 + sb * 32 + tt) * 512 + ch;
                HL[o] = (bf16)f2bf(hh); CA[o] = (bf16)f2bf(ca);
            }
        }
        PE[(size_t)item * 512 + ch] = ca; PE[(size_t)(BATCH * NCHUNK + item) * 512 + ch] = hh;
    }
    __syncthreads();
}
__device__ __forceinline__ void phase_lru_b2(const Params& p) {
    unsigned char* ws = p.ws; bf16* LG = (bf16*)(ws + WS_PROJ) + (size_t)7 * M * 512;
    const bf16* HL = (const bf16*)(ws + WS_HL); const bf16* CA = (const bf16*)(ws + WS_CA); const float* PE = (const float*)(ws + WS_LRUPE);
    const int ch = ltid();
    for (int item = blockIdx.x; item < BATCH * NCHUNK; item += gridDim.x) {
        const int b = item >> 7, c = item & (NCHUNK - 1); const size_t row0 = (size_t)b * SEQ + (size_t)c * 64;
        float carry = 0.f;
        for (int j = 0; j < c; ++j) { const size_t o = (size_t)(b * NCHUNK + j) * 512 + ch; carry = PE[(size_t)BATCH * NCHUNK * 512 + o] + PE[o] * carry; }
#pragma unroll 4
        for (int tt = 0; tt < 64; ++tt) { const size_t o = (row0 + tt) * 512 + ch;
            const float hv = bf2f(HL[o]) + bf2f(CA[o]) * carry; LG[o] = (bf16)f2bf(hv * gelu_tanh(bf2f(LG[o]))); }
    }
}

__device__ __forceinline__ void phase_band(const Params& p, int l, LAS unsigned char* lds, int blk0, int nblk) {
    unsigned char* ws = p.ws; bf16* AQ = (bf16*)(ws + WS_PROJ) + (size_t)8 * M * 512; const bf16* AK = (const bf16*)(ws + WS_PROJ) + (size_t)4 * M * 512; const bf16* AV = AK + (size_t)M * 512;
    LAS unsigned char* Qs = lds;
    LAS unsigned char* Ks = Qs + 9216;
    LAS unsigned char* Vs = Ks + 18432;
    LAS unsigned char* Ps = Vs + 18432;
    LAS float* tab = (LAS float*)(Ps + 18432);
    LAS float* st = tab + 260;
    LAS float* Ox = st + 128;
    const int tid = ltid(), lane = tid & 63, wv = tid >> 6, fr = lane & 15, fq = lane >> 4, rt = wv & 3, kh = wv >> 2;
    LAS unsigned char* Pw = Ps + wv * 2304;
    for (int item = (int)blockIdx.x - blk0; item < BATCH * NCHUNK * 8; item += nblk) {
        const int h = item & 7, c = (item >> 3) & (NCHUNK - 1), b = item >> 10;
        const size_t row0 = (size_t)b * SEQ + (size_t)c * 64;
        __syncthreads();
        if (tid < 257) tab[tid] = p.la_rel_bias[((size_t)l * 8 + h) * 257 + tid];
        { const int r = tid >> 3, c8 = tid & 7; *(LAS u32x4*)(Qs + r * 144 + c8 * 16) = *(const u32x4*)(AQ + (row0 + r) * 512 + h * 64 + c8 * 8); }
        const int c0 = c - 8 < 0 ? 0 : c - 8, nv = c - c0 + 1;
        float mrow[4], lrow[4]; f32x4 O[4];
#pragma unroll
        for (int jj = 0; jj < 4; ++jj) { mrow[jj] = -1e30f; lrow[jj] = 0.f; O[jj] = (f32x4){0.f, 0.f, 0.f, 0.f}; }
        for (int rd = 0; rd < nv; rd += 2) {
            __syncthreads();
#pragma unroll
            for (int sel = 0; sel < 2; ++sel) {
                if (rd + sel < nv) {
                    const size_t kr = (size_t)b * SEQ + (size_t)(c0 + rd + sel) * 64 + (tid >> 3); const int c8 = tid & 7;
                    *(LAS u32x4*)(Ks + sel * 9216 + (tid >> 3) * 144 + c8 * 16) = *(const u32x4*)(AK + kr * 512 + h * 64 + c8 * 8);
                    const u32x4 vv = *(const u32x4*)(AV + kr * 512 + h * 64 + c8 * 8);
                    LAS unsigned short* vt = (LAS unsigned short*)(Vs + sel * 9216) + (c8 * 8) * 72 + (tid >> 3);
                    vt[0 * 72] = (unsigned short)(vv.x & 0xffffu); vt[1 * 72] = (unsigned short)(vv.x >> 16); vt[2 * 72] = (unsigned short)(vv.y & 0xffffu); vt[3 * 72] = (unsigned short)(vv.y >> 16);
                    vt[4 * 72] = (unsigned short)(vv.z & 0xffffu); vt[5 * 72] = (unsigned short)(vv.z >> 16); vt[6 * 72] = (unsigned short)(vv.w & 0xffffu); vt[7 * 72] = (unsigned short)(vv.w >> 16);
                }
            }
            __syncthreads();
            if (rd + kh < nv) {
                const int kc = c0 + rd + kh;
                const LAS unsigned char* Kb = Ks + kh * 9216; const LAS unsigned char* Vb = Vs + kh * 9216;
                f32x4 s[4];
#pragma unroll
                for (int nt = 0; nt < 4; ++nt) { s[nt] = (f32x4){0.f, 0.f, 0.f, 0.f};
#pragma unroll
                    for (int ks = 0; ks < 2; ++ks) s[nt] = mfma16(ldfrag(Qs, rt * 16 + fr, 144, ks * 32 + fq * 8), ldfrag(Kb, nt * 16 + fr, 144, ks * 32 + fq * 8), s[nt]); }
                const int relb = (kc - c) * 64 - (rt * 16 + fq * 4);
#pragma unroll
                for (int jj = 0; jj < 4; ++jj) {
                    float mx = -1e30f;
#pragma unroll
                    for (int nt = 0; nt < 4; ++nt) { int rel = relb + nt * 16 + fr - jj; rel = rel < -128 ? -128 : (rel > 128 ? 128 : rel);
                        const float v = s[nt][jj] * 0.125f + tab[rel + 128]; s[nt][jj] = v; mx = fmaxf(mx, v); }
                    mx = fmaxf(mx, __shfl_xor(mx, 1)); mx = fmaxf(mx, __shfl_xor(mx, 2)); mx = fmaxf(mx, __shfl_xor(mx, 4)); mx = fmaxf(mx, __shfl_xor(mx, 8));
                    const float mn = fmaxf(mrow[jj], mx), sc = __expf(mrow[jj] - mn); mrow[jj] = mn;
                    float ps = 0.f;
#pragma unroll
                    for (int nt = 0; nt < 4; ++nt) { const float pe = __expf(s[nt][jj] - mn); ps += pe; *(LAS unsigned short*)(Pw + (fq * 4 + jj) * 144 + (nt * 16 + fr) * 2) = (unsigned short)f2bf(pe); }
                    ps += __shfl_xor(ps, 1); ps += __shfl_xor(ps, 2); ps += __shfl_xor(ps, 4); ps += __shfl_xor(ps, 8);
                    lrow[jj] = lrow[jj] * sc + ps;
#pragma unroll
                    for (int dtile = 0; dtile < 4; ++dtile) O[dtile][jj] *= sc;
                }
                asm volatile("s_waitcnt lgkmcnt(0)" ::: "memory");
#pragma unroll
                for (int ks = 0; ks < 2; ++ks) { const bf16x8 pa = ldfrag(Pw, fr, 144, ks * 32 + fq * 8);
#pragma unroll
                    for (int dtile = 0; dtile < 4; ++dtile) O[dtile] = mfma16(pa, ldfrag(Vb, dtile * 16 + fr, 144, ks * 32 + fq * 8), O[dtile]); }
            }
        }
        if (kh == 1) {
#pragma unroll
            for (int jj = 0; jj < 4; ++jj) { const int q = rt * 16 + fq * 4 + jj; if (fr == 0) { st[q] = mrow[jj]; st[64 + q] = lrow[jj]; }
#pragma unroll
                for (int dtile = 0; dtile < 4; ++dtile) Ox[q * 65 + dtile * 16 + fr] = O[dtile][jj]; }
        }
        __syncthreads();
        if (kh == 0) {
#pragma unroll
            for (int jj = 0; jj < 4; ++jj) { const int q = rt * 16 + fq * 4 + jj; const float m1 = st[q], l1 = st[64 + q];
                const float mn = fmaxf(mrow[jj], m1), a0 = __expf(mrow[jj] - mn), a1 = __expf(m1 - mn); const float inv = 1.f / (lrow[jj] * a0 + l1 * a1);
#pragma unroll
                for (int dtile = 0; dtile < 4; ++dtile) { const float o = (O[dtile][jj] * a0 + Ox[q * 65 + dtile * 16 + fr] * a1) * inv;
                    AQ[(row0 + q) * 512 + h * 64 + dtile * 16 + fr] = (bf16)f2bf(o); } }
        }
    }
    __syncthreads();
}

__device__ __forceinline__ void phase_vt(const Params& p) {
    unsigned char* ws = p.ws; const bf16* KV = (const bf16*)(ws + WS_KV); bf16* VT = (bf16*)(ws + WS_VT);
    for (int idx = GTID; idx < BATCH * 4 * 256 * 256; idx += GSZ) { const int key = idx & 255, d = (idx >> 8) & 255, h = (idx >> 16) & 3, b = idx >> 18;
        VT[idx] = KV[(size_t)(b * 256 + key) * 2048 + 1024 + h * 256 + d]; }
}
__device__ __forceinline__ void phase_xa(const Params& p, LAS unsigned char* lds) {
    unsigned char* ws = p.ws; const bf16* Q = (const bf16*)(ws + WS_Q); const bf16* KV = (const bf16*)(ws + WS_KV); const bf16* VT = (const bf16*)(ws + WS_VT); bf16* O = (bf16*)(ws + WS_O);
    LAS unsigned char* Qs = lds;
    LAS unsigned char* KVs = Qs + 33792;
    LAS unsigned char* Ps = KVs + 67584;
    LAS float* stm = (LAS float*)(Ps + 33792);
    LAS float* stl = stm + 128;
    const int tid = ltid(), lane = tid & 63, wv = tid >> 6, fr = lane & 15, fq = lane >> 4, rt = wv & 3, kq = wv >> 2;
    for (int item = blockIdx.x; item < BATCH * (SEQ / 64) * 4; item += gridDim.x) {
        const int h = item & 3, tile = item >> 2; const int b = tile >> 7; const size_t row0 = (size_t)tile * 64;
        __syncthreads();
#pragma unroll
        for (int k = 0; k < 4; ++k) { const int pp = tid + 512 * k, r = pp >> 5, c32 = pp & 31; *(LAS u32x4*)(Qs + r * 528 + c32 * 16) = *(const u32x4*)(Q + (row0 + r) * D + h * 256 + c32 * 8); }
        f32x4 s[2][4];
#pragma unroll
        for (int kh2 = 0; kh2 < 2; ++kh2) {
            if (kh2) __syncthreads();
#pragma unroll
            for (int k = 0; k < 8; ++k) { const int pp = tid + 512 * k, r = pp >> 5, c32 = pp & 31;
                *(LAS u32x4*)(KVs + r * 528 + c32 * 16) = *(const u32x4*)(KV + (size_t)(b * 256 + kh2 * 128 + r) * 2048 + h * 256 + c32 * 8); }
            __syncthreads();
#pragma unroll
            for (int nt = 0; nt < 4; ++nt) { f32x4 a = {0.f, 0.f, 0.f, 0.f};
#pragma unroll
                for (int ks = 0; ks < 8; ++ks) a = mfma16(ldfrag(Qs, rt * 16 + fr, 528, ks * 32 + fq * 8), ldfrag(KVs, kq * 64 + nt * 16 + fr, 528, ks * 32 + fq * 8), a);
                s[kh2][nt] = a * 0.0625f; }
        }
        float mx[4];
#pragma unroll
        for (int jj = 0; jj < 4; ++jj) { float m = -1e30f;
#pragma unroll
            for (int kh2 = 0; kh2 < 2; ++kh2)
#pragma unroll
                for (int nt = 0; nt < 4; ++nt) m = fmaxf(m, s[kh2][nt][jj]);
            m = fmaxf(m, __shfl_xor(m, 1)); m = fmaxf(m, __shfl_xor(m, 2)); m = fmaxf(m, __shfl_xor(m, 4)); m = fmaxf(m, __shfl_xor(m, 8));
            mx[jj] = m; if (fr == 0) stm[kq * 64 + rt * 16 + fq * 4 + jj] = m; }
        __syncthreads();
        float ls[4];
#pragma unroll
        for (int jj = 0; jj < 4; ++jj) { const int q = rt * 16 + fq * 4 + jj; const float m = fmaxf(stm[q], stm[64 + q]); float l = 0.f;
#pragma unroll
            for (int kh2 = 0; kh2 < 2; ++kh2)
#pragma unroll
                for (int nt = 0; nt < 4; ++nt) { const float pe = __expf(s[kh2][nt][jj] - m); s[kh2][nt][jj] = pe; l += pe; }
            l += __shfl_xor(l, 1); l += __shfl_xor(l, 2); l += __shfl_xor(l, 4); l += __shfl_xor(l, 8);
            ls[jj] = l; if (fr == 0) stl[kq * 64 + q] = l; }
        __syncthreads();
#pragma unroll
        for (int jj = 0; jj < 4; ++jj) { const int q = rt * 16 + fq * 4 + jj; const float inv = 1.f / (stl[q] + stl[64 + q]);
#pragma unroll
            for (int kh2 = 0; kh2 < 2; ++kh2)
#pragma unroll
                for (int nt = 0; nt < 4; ++nt) *(LAS unsigned short*)(Ps + q * 528 + (kh2 * 128 + kq * 64 + nt * 16 + fr) * 2) = (unsigned short)f2bf(s[kh2][nt][jj] * inv); }
#pragma unroll 1
        for (int dh = 0; dh < 2; ++dh) {
            __syncthreads();
#pragma unroll
            for (int k = 0; k < 8; ++k) { const int pp = tid + 512 * k, r = pp >> 5, c32 = pp & 31;
                *(LAS u32x4*)(KVs + r * 528 + c32 * 16) = *(const u32x4*)(VT + ((size_t)(b * 4 + h) * 256 + dh * 128 + r) * 256 + c32 * 8); }
            __syncthreads();
#pragma unroll
            for (int nt = 0; nt < 4; ++nt) { f32x4 a = {0.f, 0.f, 0.f, 0.f};
#pragma unroll
                for (int ks = 0; ks < 8; ++ks) a = mfma16(ldfrag(Ps, rt * 16 + fr, 528, ks * 32 + fq * 8), ldfrag(KVs, kq * 64 + nt * 16 + fr, 528, ks * 32 + fq * 8), a);
#pragma unroll
                for (int jj = 0; jj < 4; ++jj) O[(row0 + rt * 16 + fq * 4 + jj) * D + h * 256 + dh * 128 + kq * 64 + nt * 16 + fr] = (bf16)f2bf(a[jj]); }
        }
    }
    __syncthreads();
}

__device__ __forceinline__ void phase_xa_naive(const Params& p, LAS unsigned char* lds) {
    unsigned char* ws = p.ws; const bf16* Q = (const bf16*)(ws + WS_Q); const bf16* KV = (const bf16*)(ws + WS_KV); bf16* O = (bf16*)(ws + WS_O);
    const int lane = ltid() & 63, wv = ltid() >> 6;
    LAS float* pl = (LAS float*)lds + wv * 512;
    for (int it = GWAVE; it < M * 4; it += NGWAVE) {
        const int row = it >> 2, h = it & 3, b = row >> 13;
        { const uint2 qv = *((const uint2*)(Q + (size_t)row * D + h * 256) + lane); pl[256 + 4 * lane] = bflo(qv.x); pl[256 + 4 * lane + 1] = bfhi(qv.x); pl[256 + 4 * lane + 2] = bflo(qv.y); pl[256 + 4 * lane + 3] = bfhi(qv.y); }
        asm volatile("s_waitcnt lgkmcnt(0)" ::: "memory");
        float s[4];
#pragma unroll
        for (int j = 0; j < 4; ++j) {
            const bf16* kr = KV + (size_t)(b * 256 + lane + 64 * j) * 2048 + h * 256; float acc = 0.f;
            for (int d0 = 0; d0 < 256; d0 += 8) { const u32x4 v = *(const u32x4*)(kr + d0); const LAS float* qq = pl + 256 + d0;
                acc += qq[0] * bflo(v.x) + qq[1] * bfhi(v.x) + qq[2] * bflo(v.y) + qq[3] * bfhi(v.y) + qq[4] * bflo(v.z) + qq[5] * bfhi(v.z) + qq[6] * bflo(v.w) + qq[7] * bfhi(v.w); }
            s[j] = acc * 0.0625f;
        }
        const float mx = wave_max(fmaxf(fmaxf(s[0], s[1]), fmaxf(s[2], s[3])));
        float ls = 0.f;
#pragma unroll
        for (int j = 0; j < 4; ++j) { s[j] = __expf(s[j] - mx); ls += s[j]; }
        ls = wave_sum(ls); const float inv = 1.f / ls;
#pragma unroll
        for (int j = 0; j < 4; ++j) pl[lane + 64 * j] = s[j] * inv;
        asm volatile("s_waitcnt lgkmcnt(0)" ::: "memory");
        float o0 = 0, o1 = 0, o2 = 0, o3 = 0;
        for (int key = 0; key < 256; ++key) { const float pp = pl[key]; const uint2 v = *((const uint2*)(KV + (size_t)(b * 256 + key) * 2048 + 1024 + h * 256) + lane);
            o0 += pp * bflo(v.x); o1 += pp * bfhi(v.x); o2 += pp * bflo(v.y); o3 += pp * bfhi(v.y); }
        uint2 w; w.x = pk2(o0, o1); w.y = pk2(o2, o3); *((uint2*)(O + (size_t)row * D + h * 256) + lane) = w;
        asm volatile("s_waitcnt lgkmcnt(0)" ::: "memory");
    }
}

#define GEMM_BF16(Aptr, Btptr, Mr, Nc, Kk, Optr, ldo, splitc, splits) do { pg8::Gemm g_{Aptr, Btptr, Mr, Nc, Kk}; pg8::StaticOrder S_; S_.init(Mr, Nc, (int)gridDim.x, (int)blockIdx.x); \
    pg8::EpiBf16<0> E_{Optr, ldo, nullptr, splitc, splits, 1.f}; pg8::gemm_phase<pg8::EpiBf16<0>, pg8::StaticOrder, true, true>(lds, g_, S_, E_); } while (0)
#define GEMM_RESID(Aptr, Btptr, Kk, Xs, Xd, al, sc) do { pg8::Gemm g_{Aptr, Btptr, M, D, Kk}; pg8::StaticOrder S_; S_.init(M, D, (int)gridDim.x, (int)blockIdx.x); \
    pg8::EpiResid E_{Xs, Xd, al, sc}; pg8::gemm_phase<pg8::EpiResid, pg8::StaticOrder, true, true>(lds, g_, S_, E_); } while (0)

__global__ void __launch_bounds__(NT) fwd_megakernel(Params p) {
    extern __shared__ __attribute__((aligned(16))) unsigned char lds_raw[];
    LAS unsigned char* lds = (LAS unsigned char*)lds_raw;
    cg::grid_group grid = cg::this_grid();
    unsigned char* ws = p.ws;
    bf16* XB = (bf16*)(ws + WS_XB); float* X = p.out;
    bf16* H = (bf16*)(ws + WS_H);
    bf16* PROJ = (bf16*)(ws + WS_PROJ);
    bf16* GL = (bf16*)(ws + WS_GL);
    bf16* MERGEDB = (bf16*)(ws + WS_MERGEDB);
    bf16* Qb = (bf16*)(ws + WS_Q); bf16* Ob = (bf16*)(ws + WS_O);
    bf16* KV = (bf16*)(ws + WS_KV); bf16* MEMB = (bf16*)(ws + WS_MEMB);
    float* BA = (float*)(ws + WS_BA);
    const bf16* W12T = (const bf16*)(ws + WS_W12T); const bf16* W3T = (const bf16*)(ws + WS_W3T); const bf16* WINT = (const bf16*)(ws + WS_WINT);
    const bf16* WBRT = (const bf16*)(ws + WS_WBRT); const bf16* WOUTT = (const bf16*)(ws + WS_WOUTT); const bf16* WQT = (const bf16*)(ws + WS_WQT);
    const bf16* WOT = (const bf16*)(ws + WS_WOT); const bf16* WKVT = (const bf16*)(ws + WS_WKVT);

    phase_convert(p, 0, lds);
    cvt_rows(p.mem, MEMB, (size_t)512 * D);
    cvt_rows(p.x, XB, (size_t)M * D);
    __syncthreads();
    grid.sync();

#pragma unroll 1
    for (int l = 0; l < DEPTH; ++l) {
        const float* lg = p.ln_g + (size_t)l * 4 * D; const float* lb = p.ln_b + (size_t)l * 4 * D;
        GEMM_BF16(MEMB, WKVT, 512, 2 * D, D, KV, 2 * D, 0, 0);
#pragma unroll 1
        for (int f = 0; f < 2; ++f) {
            if (f == 1) {
                GEMM_BF16(XB, WINT, M, 4608, D, PROJ, 512, 512, (size_t)M * 512);
                grid.sync();
                phase_dn_prep(p, l, lds);
                __syncthreads();
                grid.sync();
                if (gridDim.x >= 128) {
                    if (blockIdx.x < 64) phase_dn_scan(p, lds, (bf16*)(ws + WS_PROJ));
                    else { phase_band(p, l, lds, 64, (int)gridDim.x - 64); phase_lru_b1(p, l, lds, 64, (int)gridDim.x - 64); }
                } else { phase_dn_scan(p, lds, (bf16*)(ws + WS_PROJ)); __syncthreads(); phase_band(p, l, lds, 0, (int)gridDim.x); phase_lru_b1(p, l, lds, 0, (int)gridDim.x); }
                __syncthreads();
                grid.sync();
                phase_dn_post(p, l, (const bf16*)(ws + WS_PROJ));
                phase_lru_b2(p);
                __syncthreads();
                grid.sync();
                GEMM_BF16(XB, WINT + (size_t)4608 * D, M, 3072, D, GL, 3072, 0, 0);
                grid.sync();
                {
                    pg8::Gemm g_{PROJ + (size_t)6 * M * 512, WBRT, 3 * M, 3 * D, 512}; pg8::BranchOrder S_; S_.init((int)gridDim.x, (int)blockIdx.x);
                    pg8::EpiBranch E_{GL, (float*)(ws + WS_PROJ), MERGEDB};
                    pg8::gemm_phase<pg8::EpiBranch, pg8::BranchOrder, true, true>(lds, g_, S_, E_);
                }
                grid.sync();
                GEMM_RESID(MERGEDB, WOUTT, D, X, X, ALPHA, 1.f);
                grid.sync();
                phase_ln(X, XB, lg + 1 * D, lb + 1 * D, nullptr, nullptr);
                grid.sync();
                GEMM_BF16(XB, WQT, M, D, D, Qb, D, 0, 0);
                grid.sync();
#ifdef XA_NAIVE
                phase_xa_naive(p, lds);
#else
                phase_xa(p, lds);
#endif
                __syncthreads();
                grid.sync();
                GEMM_RESID(Ob, WOT, D, X, X, ALPHA, 1.f);
                grid.sync();
                phase_ln(X, XB, lg + 2 * D, lb + 2 * D, nullptr, nullptr);
                grid.sync();
            }
            {
                pg8::Gemm g_{XB, W12T + (size_t)f * 2 * FF * D, M, 2 * FF, D}; pg8::StaticOrder S_; S_.init(M, 2 * FF, (int)gridDim.x, (int)blockIdx.x);
                pg8::EpiSwiglu E_{H, FF};
                pg8::gemm_phase<pg8::EpiSwiglu, pg8::StaticOrder, true, true>(lds, g_, S_, E_);
            }
            grid.sync();
            if (f == 0) phase_vt(p);
            {
                const float* Xsrc = (l == 0 && f == 0) ? p.x : X;
                GEMM_RESID(H, W3T + (size_t)f * D * FF, FF, Xsrc, X, ALPHA, 0.5f);
            }
            grid.sync();
            if (f == 0) phase_ln(X, XB, lg, lb, BA, p.mix_w_in + (size_t)l * D * NIN);
            else { phase_ln(X, XB, lg + 3 * D, lb + 3 * D, nullptr, nullptr); if (l + 1 < DEPTH) { __syncthreads(); phase_convert(p, l + 1, lds); __syncthreads(); } }
            grid.sync();
        }
    }
}

extern "C" void kernel_launch(void* const* d_in, const int* in_sizes, int n_in, void* d_out, int out_size, void* d_ws, size_t ws_size, hipStream_t stream) {
    static int grid_blocks = 0;
    if (grid_blocks == 0) {
        if (n_in != 22 || ws_size < WS_END) { fprintf(stderr, "kernel_launch: unexpected n_in %d or ws_size %zu (< %zu)\n", n_in, ws_size, (size_t)WS_END); grid_blocks = -1; return; }
        int dev = 0, cus = 0, per_cu = 0;
        hipGetDevice(&dev);
        hipDeviceGetAttribute(&cus, hipDeviceAttributeMultiprocessorCount, dev);
        hipFuncSetAttribute((const void*)fwd_megakernel, hipFuncAttributeMaxDynamicSharedMemorySize, LDS_BYTES);
        hipOccupancyMaxActiveBlocksPerMultiprocessor(&per_cu, (const void*)fwd_megakernel, NT, LDS_BYTES);
        if (per_cu < 1) per_cu = 1;
        grid_blocks = cus * per_cu;
    }
    if (grid_blocks < 0) return;
    Params p{};
    const float** pp = (const float**)&p;
    for (int i = 0; i < 22; ++i) pp[i] = (const float*)d_in[i];
    p.out = (float*)d_out; p.ws = (unsigned char*)d_ws;
    void* args[] = {&p};
    hipError_t e = hipLaunchCooperativeKernel((const void*)fwd_megakernel, dim3(grid_blocks), dim3(NT), args, LDS_BYTES, stream);
    if (e != hipSuccess) fprintf(stderr, "cooperative launch failed: %s (grid %d)\n", hipGetErrorString(e), grid_blocks);
}
```
